# Optimizing an MI355X kernel written in HIP

```python
import math
import jax, jax.numpy as jnp
from jax import lax
import numpy as np

D_MODEL = 1024
BATCH = 8
SEQ = 4096
DEPTH = 4

HEAD_DIM = 64
ATT_GROUPS = ((128, 1), (512, 4), (2048, 16))
N_GROUPS = len(ATT_GROUPS)
HEADS_PER_GROUP = 4
N_ATT_QKV_HEADS = N_GROUPS * HEADS_PER_GROUP
D_ATT_QKV = N_ATT_QKV_HEADS * HEAD_DIM
D_ATT_OUT = HEADS_PER_GROUP * HEAD_DIM
ALIBI_MAX_BIAS = 8.0
D_LRU = (3 * D_MODEL) // 4
LRU_BLOCK = 64
N_LRU_BLOCKS = D_LRU // LRU_BLOCK
CONV_WIDTH = 4
LRU_C = 8.0
D_MIX = D_ATT_OUT + D_LRU
D_IN_PROJ = 3 * D_ATT_QKV + 2 * D_LRU
D_FF = 2816
FFN_RES_WEIGHT = 0.5
RMS_EPS = 1e-6
NEG_INF = -1e30

kernel_name = "hybrid_dilated_attn_rglru_macaron"


def rms_norm(x, gain):
    xf = x.astype(jnp.float32)
    y = xf * lax.rsqrt(jnp.mean(xf * xf, axis=-1, keepdims=True) + RMS_EPS)
    return (y * gain.astype(jnp.float32)).astype(x.dtype)


def swiglu(h, w_gate, w_up, w_down):
    return (jax.nn.silu(h @ w_gate) * (h @ w_up)) @ w_down


def alibi_slopes():
    h = jnp.arange(1, N_ATT_QKV_HEADS + 1, dtype=jnp.float32)
    return jnp.exp2(-ALIBI_MAX_BIAS * h / N_ATT_QKV_HEADS).reshape(N_GROUPS, HEADS_PER_GROUP)


def dilated_window_attention(q, k, v, window, dilation, slopes):
    B, S, H, Dh = q.shape
    n = window // dilation
    span = n * dilation
    s_pad = -(-S // span) * span
    L = s_pad // dilation
    nb = L // n

    def to_blocks(t):
        t = jnp.pad(t.astype(jnp.float32), ((0, 0), (0, s_pad - S), (0, 0), (0, 0)))
        t = t.reshape(B, L, dilation, H, Dh).transpose(0, 2, 3, 1, 4)
        return t.reshape(B, dilation, H, nb, n, Dh)

    def with_prev(t):
        prev = jnp.concatenate([jnp.zeros_like(t[:, :, :, :1]), t[:, :, :, :-1]], axis=3)
        return jnp.concatenate([prev, t], axis=4)

    qb = to_blocks(q)
    kw = with_prev(to_blocks(k))
    vw = with_prev(to_blocks(v))
    scores = jnp.einsum('brhnid,brhnkd->brhnik', qb, kw) / math.sqrt(Dh)
    qi = jnp.arange(n)[:, None]
    ki = jnp.arange(2 * n)[None, :]
    steps = n + qi - ki
    blk = jnp.arange(nb)[:, None, None]
    valid = (steps >= 0) & (steps <= n) & (blk * n + ki - n >= 0)
    bias = -slopes[:, None, None, None] * (dilation * steps).astype(jnp.float32)
    scores = jnp.where(valid, scores + bias, NEG_INF)
    lse = jax.nn.logsumexp(scores, axis=-1)
    p = jnp.exp(scores - lse[..., None])
    out = jnp.einsum('brhnik,brhnkd->brhnid', p, vw)
    out = out.reshape(B, dilation, H, L, Dh).transpose(0, 3, 1, 2, 4).reshape(B, s_pad, H, Dh)[:, :S]
    lse = lse.reshape(B, dilation, H, L).transpose(0, 3, 1, 2).reshape(B, s_pad, H)[:, :S]
    return out, lse


def causal_depthwise_conv(x, w, b):
    y = lax.conv_general_dilated(
        x, w[:, None, :].astype(x.dtype), window_strides=(1,),
        padding=((CONV_WIDTH - 1, 0),),
        dimension_numbers=('NWC', 'WIO', 'NWC'),
        feature_group_count=x.shape[-1])
    return y + b


def _linear_recurrence_combine(c1, c2):
    a1, b1 = c1
    a2, b2 = c2
    return a1 * a2, a2 * b1 + b2


def rg_lru(x, gate_a_w, gate_a_b, gate_x_w, gate_x_b, lam):
    B, S, C = x.shape
    xf = x.astype(jnp.float32)
    xh = xf.reshape(B, S, N_LRU_BLOCKS, LRU_BLOCK)
    r = jax.nn.sigmoid(jnp.einsum('bshi,hij->bshj', xh, gate_a_w.astype(jnp.float32)).reshape(B, S, C)
                       + gate_a_b.astype(jnp.float32))
    ig = jax.nn.sigmoid(jnp.einsum('bshi,hij->bshj', xh, gate_x_w.astype(jnp.float32)).reshape(B, S, C)
                        + gate_x_b.astype(jnp.float32))
    log_a = -LRU_C * r * jax.nn.softplus(-lam.astype(jnp.float32))
    a = jnp.exp(log_a)
    b = jnp.sqrt(-jnp.expm1(2.0 * log_a)) * (ig * xf)
    _, h = lax.associative_scan(_linear_recurrence_combine, (a, b), axis=1)
    return h.astype(x.dtype)


def setup_inputs(seed: int = 0) -> dict:
    key = jax.random.key(seed)
    ks = jax.random.split(key, 24)

    def normal(k, shape, scale):
        return jax.random.normal(k, shape, jnp.float32) * scale

    def gain(k, shape):
        return 1.0 + 0.02 * jax.random.normal(k, shape, jnp.float32)

    u = jax.random.uniform(ks[14], (DEPTH, D_LRU), jnp.float32, 0.9, 0.999)
    a0 = u ** (1.0 / LRU_C)
    lru_lambda = jnp.log(a0) - jnp.log1p(-a0)
    return {
        "x": normal(ks[0], (BATCH, SEQ, D_MODEL), 1.0),
        "ffn1_norm": gain(ks[1], (DEPTH, D_MODEL)),
        "ffn1_w_gate": normal(ks[2], (DEPTH, D_MODEL, D_FF), D_MODEL ** -0.5),
        "ffn1_w_up": normal(ks[3], (DEPTH, D_MODEL, D_FF), D_MODEL ** -0.5),
        "ffn1_w_down": normal(ks[4], (DEPTH, D_FF, D_MODEL), D_FF ** -0.5),
        "mix_norm": gain(ks[5], (DEPTH, D_MODEL)),
        "w_in": normal(ks[6], (DEPTH, D_MODEL, D_IN_PROJ), D_MODEL ** -0.5),
        "q_norm": gain(ks[7], (DEPTH, HEAD_DIM)),
        "k_norm": gain(ks[8], (DEPTH, HEAD_DIM)),
        "conv_w": normal(ks[9], (DEPTH, CONV_WIDTH, D_LRU), CONV_WIDTH ** -0.5),
        "conv_b": normal(ks[10], (DEPTH, D_LRU), 0.01),
        "gate_a_w": normal(ks[11], (DEPTH, N_LRU_BLOCKS, LRU_BLOCK, LRU_BLOCK), LRU_BLOCK ** -0.5),
        "gate_a_b": normal(ks[12], (DEPTH, D_LRU), 0.01),
        "gate_x_w": normal(ks[13], (DEPTH, N_LRU_BLOCKS, LRU_BLOCK, LRU_BLOCK), LRU_BLOCK ** -0.5),
        "gate_x_b": normal(ks[15], (DEPTH, D_LRU), 0.01),
        "lru_lambda": lru_lambda,
        "w_out": normal(ks[16], (DEPTH, D_MIX, D_MODEL), D_MIX ** -0.5),
        "ffn2_norm": gain(ks[17], (DEPTH, D_MODEL)),
        "ffn2_w_gate": normal(ks[18], (DEPTH, D_MODEL, D_FF), D_MODEL ** -0.5),
        "ffn2_w_up": normal(ks[19], (DEPTH, D_MODEL, D_FF), D_MODEL ** -0.5),
        "ffn2_w_down": normal(ks[20], (DEPTH, D_FF, D_MODEL), D_FF ** -0.5),
    }


def reference(x, ffn1_norm, ffn1_w_gate, ffn1_w_up, ffn1_w_down, mix_norm, w_in,
              q_norm, k_norm, conv_w, conv_b, gate_a_w, gate_a_b, gate_x_w, gate_x_b,
              lru_lambda, w_out, ffn2_norm, ffn2_w_gate, ffn2_w_up, ffn2_w_down):
    B, S, _ = x.shape
    slopes = alibi_slopes()
    for l in range(DEPTH):
        x = x + FFN_RES_WEIGHT * swiglu(rms_norm(x, ffn1_norm[l]), ffn1_w_gate[l], ffn1_w_up[l], ffn1_w_down[l])

        h = rms_norm(x, mix_norm[l])
        proj = h @ w_in[l]
        q, k, v, lru_x, lru_gate = jnp.split(
            proj, [D_ATT_QKV, 2 * D_ATT_QKV, 3 * D_ATT_QKV, 3 * D_ATT_QKV + D_LRU], axis=-1)
        q = rms_norm(q.reshape(B, S, N_GROUPS, HEADS_PER_GROUP, HEAD_DIM), q_norm[l])
        k = rms_norm(k.reshape(B, S, N_GROUPS, HEADS_PER_GROUP, HEAD_DIM), k_norm[l])
        v = v.reshape(B, S, N_GROUPS, HEADS_PER_GROUP, HEAD_DIM)

        outs, lses = [], []
        for g, (window, dilation) in enumerate(ATT_GROUPS):
            o_g, lse_g = dilated_window_attention(q[:, :, g], k[:, :, g], v[:, :, g], window, dilation, slopes[g])
            outs.append(o_g)
            lses.append(lse_g)
        w_grp = jax.nn.softmax(jnp.stack(lses, axis=0), axis=0)
        att = jnp.sum(w_grp[..., None] * jnp.stack(outs, axis=0), axis=0)
        att = att.reshape(B, S, D_ATT_OUT).astype(x.dtype)

        xc = causal_depthwise_conv(lru_x, conv_w[l], conv_b[l])
        y = rg_lru(xc, gate_a_w[l], gate_a_b[l], gate_x_w[l], gate_x_b[l], lru_lambda[l])
        y = y * jax.nn.gelu(lru_gate)

        x = x + jnp.concatenate([att, y], axis=-1) @ w_out[l]

        x = x + FFN_RES_WEIGHT * swiglu(rms_norm(x, ffn2_norm[l]), ffn2_w_gate[l], ffn2_w_up[l], ffn2_w_down[l])
    return x
```

```cpp
#include <hip/hip_runtime.h>
#include <hip/hip_cooperative_groups.h>
#include <cstdio>
#include <cstdint>
namespace cg = cooperative_groups;

#ifndef MK_ONE_LAUNCH
#define MK_ONE_LAUNCH 1
#endif
#define DUP_UP 0
#define DUP_SMASK 0
#define DUP_IN 0
#define DUP_CONV 0
#define DUP_LRU1 0
#define DUP_ATT 0
#define DUP_LRU2 0

#define LAS __attribute__((address_space(3)))
typedef unsigned short bf16_t;
typedef short bf16x8 __attribute__((ext_vector_type(8)));
typedef short s16x4 __attribute__((ext_vector_type(4)));
typedef float f32x4 __attribute__((ext_vector_type(4)));
typedef float f32x2 __attribute__((ext_vector_type(2)));
typedef unsigned u32x4 __attribute__((ext_vector_type(4)));
typedef unsigned u32x2 __attribute__((ext_vector_type(2)));

constexpr int DM = 1024, NBATCH = 8, SEQ = 4096, DEPTH = 4, MTOK = NBATCH * SEQ;
constexpr int DFF = 2816, DIN = 3840, DLRU = 768;
constexpr int QOFF = 0, KOFF = 768, VOFF = 1536, LXOFF = 2304, LGOFF = 3072;
constexpr float RMS_EPS = 1e-6f, LOG2E = 1.4426950408889634f;
constexpr int NPH = 1 + 8 * DEPTH;

constexpr size_t MiB = 1u << 20;
constexpr size_t WS_ROWSQ = 0;
constexpr size_t WS_SUMM = 2 * MiB;
constexpr size_t WS_W = 4 * MiB;
constexpr size_t WS_XT = 48 * MiB;
#define XB_PTR(a) ((bf16_t*)((a).ws + 112 * MiB))
#define MIX_PTR(a) ((bf16_t*)(a).out + (size_t)MTOK * DM)
constexpr size_t WS_BIG = 176 * MiB;
constexpr size_t WS_END = 416 * MiB;
constexpr size_t W_GU1 = 0, W_D1 = W_GU1 + (size_t)2 * DFF * DM, W_IN = W_D1 + (size_t)DM * DFF, W_OUT = W_IN + (size_t)DIN * DM,
                 W_GU2 = W_OUT + (size_t)DM * DM, W_D2 = W_GU2 + (size_t)2 * DFF * DM, W_TOT = W_D2 + (size_t)DM * DFF;
static_assert(WS_W + W_TOT * 2 <= 48 * MiB, "weights fit");

constexpr int LDS_BYTES = 147456;

struct Args { const float* in[21]; float* out; unsigned char* ws; int ph_lo, ph_hi; };

__device__ __forceinline__ unsigned cvt_pk_bf16(float lo, float hi) { unsigned r; asm volatile("v_cvt_pk_bf16_f32 %0, %1, %2" : "=v"(r) : "v"(lo), "v"(hi)); return r; }
__device__ __forceinline__ float bf2f(unsigned short b) { return __uint_as_float(((unsigned)b) << 16); }
__device__ __forceinline__ float bflo(unsigned w) { return __uint_as_float(w << 16); }
__device__ __forceinline__ float bfhi(unsigned w) { return __uint_as_float(w & 0xffff0000u); }
__device__ __forceinline__ float fast_rcp(float x) { return __builtin_amdgcn_rcpf(x); }
__device__ __forceinline__ float fast_exp(float x) { return __builtin_amdgcn_exp2f(x * LOG2E); }
__device__ __forceinline__ float sigmoidf_(float x) { return fast_rcp(1.0f + fast_exp(-x)); }
__device__ __forceinline__ float wave_sum(float v) {
#pragma unroll
    for (int o = 1; o < 64; o <<= 1) v += __shfl_xor(v, o);
    return v;
}
__device__ __forceinline__ float wave_max(float v) {
#pragma unroll
    for (int o = 1; o < 64; o <<= 1) v = fmaxf(v, __shfl_xor(v, o));
    return v;
}
#define LDS_WAIT() asm volatile("s_waitcnt lgkmcnt(0)" ::: "memory")

namespace pg8 {
constexpr int BM = 256, BK = 64, HALF = 128, HTB = HALF * BK * 2, STAGE_BYTES = 8 * HTB, NXCD = 8, WGM = 8;
__host__ __device__ __forceinline__ int lds_byte(int r, int c) { const int st = (r >> 4) * 2 + (c >> 5), rr = r & 15, cc = c & 31, ob = rr * 64 + cc * 2; return st * 1024 + (ob ^ (((ob >> 9) & 1) << 5)); }
__host__ __device__ __forceinline__ void stage_rc(int b, int& R, int& C) { const int st = b / 1024, sb = b % 1024, swz = sb ^ (((sb >> 9) & 1) << 5); R = (st >> 1) * 16 + swz / 64; C = (st & 1) * 32 + (swz % 64) / 2; }
__host__ __device__ __forceinline__ int perm32(int rho) { const int n = rho >> 4, i = rho & 15; return 8 * (i >> 2) + 4 * n + (i & 3); }

struct Unit { int pm, pn; };
struct Gemm { const bf16_t* A; const bf16_t* Bt; int M, N, K; };

template <int NN>
struct StaticOrderT {
    static constexpr int nM = MTOK / BM, nN = NN, nwg = nM * nN;
    int G, c;
    __device__ void init(int G_, int c_) { G = G_; c = c_; }
    __device__ __forceinline__ bool next(int i, Unit& u) const {
        const int L = i * G + c; if (L >= nwg) return false;
        int wgid = L; { constexpr int q = nwg / NXCD, r = nwg % NXCD; const int xcd = wgid % NXCD, off = wgid / NXCD; wgid = (xcd < r ? xcd * (q + 1) : r * (q + 1) + (xcd - r) * q) + off; }
        constexpr int nig = WGM * nN; const int gid = wgid / nig, fm = gid * WGM, gsz = (nM - fm) < WGM ? (nM - fm) : WGM;
        u.pm = fm + ((wgid % nig) % gsz); u.pn = (wgid % nig) / gsz; return true;
    }
};

__device__ __forceinline__ float row_rstd(const float* rowsq, int r) {
    const f32x4* p = (const f32x4*)(rowsq + (size_t)r * 16); const f32x4 a = p[0], b = p[1], c = p[2], d = p[3];
    const float s = (((a[0] + a[1]) + (a[2] + a[3])) + ((b[0] + b[1]) + (b[2] + b[3]))) + (((c[0] + c[1]) + (c[2] + c[3])) + ((d[0] + d[1]) + (d[2] + d[3])));
    return __builtin_amdgcn_rsqf(s * (1.0f / DM) + RMS_EPS);
}
constexpr int RSTD_LDS = 131072;
struct EpiSwiGLU {
    static constexpr bool NEEDS_RSTD = true;
    bf16_t* H; const float* rowsq;
    __device__ __forceinline__ void operator()(const f32x4 (&acc)[2][2][4][2], const Unit& u, int wr, int wc, int fr, int fq, const LAS float* rstd) const {
        const int row0 = u.pm * BM + wr * 64 + fr, col0 = u.pn * HALF + wc * 32 + 8 * fq;
#pragma unroll
        for (int ai = 0; ai < 2; ++ai)
#pragma unroll
            for (int m = 0; m < 4; ++m) {
                const int r = row0 + ai * HALF + m * 16;
                const float rs = rstd[ai * HALF + wr * 64 + m * 16 + fr];
                float hv[8];
#pragma unroll
                for (int n = 0; n < 2; ++n)
#pragma unroll
                    for (int j = 0; j < 4; ++j) { const float g = acc[ai][0][m][n][j] * rs, up = acc[ai][1][m][n][j] * rs; hv[4 * n + j] = g * up * fast_rcp(1.0f + fast_exp(-g)); }
                u32x4 w; w.x = cvt_pk_bf16(hv[0], hv[1]); w.y = cvt_pk_bf16(hv[2], hv[3]); w.z = cvt_pk_bf16(hv[4], hv[5]); w.w = cvt_pk_bf16(hv[6], hv[7]);
                *(u32x4*)(H + (size_t)r * DFF + col0) = w;
            }
    }
};
struct EpiProj {
    static constexpr bool NEEDS_RSTD = true;
    bf16_t* O; int ldc; const float* rowsq;
    __device__ __forceinline__ void operator()(const f32x4 (&acc)[2][2][4][2], const Unit& u, int wr, int wc, int fr, int fq, const LAS float* rstd) const {
        const int row0 = u.pm * BM + wr * 64 + fr, col0 = u.pn * BM + wc * 32 + 8 * fq;
#pragma unroll
        for (int ai = 0; ai < 2; ++ai)
#pragma unroll
            for (int m = 0; m < 4; ++m) {
                const int r = row0 + ai * HALF + m * 16;
                const float rs = rstd[ai * HALF + wr * 64 + m * 16 + fr];
#pragma unroll
                for (int bj = 0; bj < 2; ++bj) {
                    const f32x4 v0 = acc[ai][bj][m][0] * rs, v1 = acc[ai][bj][m][1] * rs;
                    u32x4 w; w.x = cvt_pk_bf16(v0[0], v0[1]); w.y = cvt_pk_bf16(v0[2], v0[3]); w.z = cvt_pk_bf16(v1[0], v1[1]); w.w = cvt_pk_bf16(v1[2], v1[3]);
                    *(u32x4*)(O + (size_t)r * ldc + col0 + bj * HALF) = w;
                }
            }
    }
};
__host__ __device__ __forceinline__ size_t xt_off(int pm, int pn, int wid, int ai, int m, int bj, int hf, int lane) {
    return ((((((((size_t)(pm * 4 + pn) * 8 + wid) * 2 + ai) * 4 + m) * 2 + bj) * 2 + hf) * 64) + lane) * 4;
}
constexpr int LOB = 4;
__host__ __device__ __forceinline__ size_t lo_off(int pm, int pn, int wid, int ai, int m, int bj, int lane) {
    return (((((((size_t)(pm * 4 + pn) * 8 + wid) * 2 + ai) * 4 + m) * 2 + bj) * 64) + lane) * LOB;
}
__device__ __forceinline__ unsigned res_enc(float y) { return (__float_as_uint(y) + (1u << (15 - LOB))) >> (16 - LOB); }
__device__ __forceinline__ unsigned res_hi(unsigned bL) { return (bL + (1u << (LOB - 1))) >> LOB; }
struct EpiResid {
    static constexpr bool NEEDS_RSTD = false;
    unsigned char* LO; bf16_t* XB; float* rowsq_out; float alpha; const float* rowsq; float* OUT;
    __device__ __forceinline__ void operator()(const f32x4 (&acc)[2][2][4][2], const Unit& u, int wr, int wc, int fr, int fq, const LAS float* rstd) const {
        const int row0 = u.pm * BM + wr * 64 + fr, col0 = u.pn * BM + wc * 32 + 8 * fq, lane = fq * 16 + fr;
#pragma unroll
        for (int ai = 0; ai < 2; ++ai)
#pragma unroll
            for (int m = 0; m < 4; ++m) {
                const int r = row0 + ai * HALF + m * 16;
                unsigned char* lp = LO + lo_off(u.pm, u.pn, wr * 4 + wc, ai, m, 0, lane);
                bf16_t* hp = XB + (size_t)r * DM + col0;
                float ss = 0.f;
#pragma unroll
                for (int bj = 0; bj < 2; ++bj) {
                    const u32x4 hw = *(const u32x4*)(hp + bj * HALF);
                    unsigned lw[2]; if (LOB == 8) { const u32x2 t = *(const u32x2*)(lp + bj * 64 * LOB); lw[0] = t.x; lw[1] = t.y; } else { lw[0] = *(const unsigned*)(lp + bj * 64 * LOB); lw[1] = 0u; }
                    float y[8];
#pragma unroll
                    for (int e = 0; e < 8; ++e) {
                        const unsigned hpart = (e & 1) ? (hw[e >> 1] & 0xffff0000u) : (hw[e >> 1] << 16);
                        const unsigned w = (LOB == 8) ? lw[e >> 2] : lw[0]; const int pos = (LOB == 8) ? 8 * (e & 3) : 4 * e;
                        const int lo = ((int)(w << (32 - LOB - pos))) >> (32 - LOB);
                        y[e] = __uint_as_float(hpart + (unsigned)(lo << (16 - LOB))) + acc[ai][bj][m][e >> 2][e & 3] * alpha;
                    }
                    if (OUT) { float* rowp = OUT + (size_t)r * DM + col0 + bj * HALF; *(f32x4*)rowp = (f32x4){y[0], y[1], y[2], y[3]}; *(f32x4*)(rowp + 4) = (f32x4){y[4], y[5], y[6], y[7]}; }
                    else {
                        u32x4 nh; unsigned nl0 = 0u, nl1 = 0u;
#pragma unroll
                        for (int i = 0; i < 4; ++i) {
                            const unsigned b0 = res_enc(y[2 * i]), b1 = res_enc(y[2 * i + 1]);
                            ss += y[2 * i] * y[2 * i] + y[2 * i + 1] * y[2 * i + 1];
                            nh[i] = (res_hi(b0) & 0xffffu) | (res_hi(b1) << 16);
                            const unsigned pr = (b0 & ((1u << LOB) - 1u)) | ((b1 & ((1u << LOB) - 1u)) << LOB);
                            if (LOB == 8) { if (i < 2) nl0 |= pr << (16 * i); else nl1 |= pr << (16 * (i - 2)); } else nl0 |= pr << (8 * i);
                        }
                        *(u32x4*)(hp + bj * HALF) = nh;
                        if (LOB == 8) { u32x2 nl; nl.x = nl0; nl.y = nl1; *(u32x2*)(lp + bj * 64 * LOB) = nl; } else *(unsigned*)(lp + bj * 64 * LOB) = nl0;
                    }
                }
                if (!OUT) { ss += __shfl_xor(ss, 16); ss += __shfl_xor(ss, 32);
                    if (fq == 0) rowsq_out[(size_t)r * 16 + u.pn * 4 + wc] = ss; }
                asm volatile("" ::: "memory");
            }
    }
};

template <class Epi, class Sched>
__device__ __forceinline__ void gemm_phase(LAS unsigned char* lds, const Gemm g, const Sched& S, const Epi& E, const int tid) {
    const int wid = __builtin_amdgcn_readfirstlane(tid >> 6), lane = tid & 63, wr = wid >> 2, wc = wid & 3, fr = lane & 15, fq = lane >> 4;
    const int K = g.K, nt = K / BK;
    unsigned voffA[2], voffB[2];
#pragma unroll
    for (int i = 0; i < 2; ++i) { int R, C; stage_rc(tid * 16 + i * 8192, R, C); const int Rb = (R & ~31) + perm32(R & 31);
        voffA[i] = (unsigned)(R * K + C) * 2u; voffB[i] = (unsigned)(Rb * K + C) * 2u; }
    const size_t kstep = (size_t)(BK * 2);
    const size_t hstep = (size_t)HALF * K * 2;
    const size_t tstep = 2 * hstep;
    const unsigned ldsw = (unsigned)wid * 1024u;
    const int aoff = lds_byte(wr * 64 + fr, fq * 8), boff = lds_byte(wc * 32 + fr, fq * 8);
#define PG8_SA(b, h) (((b) * 2 + (h)) * HTB)
#define PG8_SB(b, h) ((4 + (b) * 2 + (h)) * HTB)
#define PG8_STAGE(bufoff, gbase, voff) do { _Pragma("unroll") for (int _i = 0; _i < 2; ++_i) \
        __builtin_amdgcn_global_load_lds((const unsigned*)((const char*)(gbase) + (voff)[_i]), (LAS unsigned*)(lds + (bufoff) + ldsw + _i * 8192), 16, 0, 0); } while (0)
#define PG8_LDA(dst, b, h) do { _Pragma("unroll") for (int m = 0; m < 4; ++m) _Pragma("unroll") for (int k = 0; k < 2; ++k) dst[m][k] = *(const LAS bf16x8*)(lds + PG8_SA(b, h) + aoff + m * 2048 + k * 1024); } while (0)
#define PG8_LDB(dst, b, h) do { _Pragma("unroll") for (int n = 0; n < 2; ++n) _Pragma("unroll") for (int k = 0; k < 2; ++k) dst[n][k] = *(const LAS bf16x8*)(lds + PG8_SB(b, h) + boff + n * 2048 + k * 1024); } while (0)
#define PG8_MMA(ai, bj, At, Bt) do { __builtin_amdgcn_s_setprio(1); _Pragma("unroll") for (int m = 0; m < 4; ++m) _Pragma("unroll") for (int n = 0; n < 2; ++n) _Pragma("unroll") for (int k = 0; k < 2; ++k) \
        acc[ai][bj][m][n] = __builtin_amdgcn_mfma_f32_16x16x32_bf16(Bt[n][k], At[m][k], acc[ai][bj][m][n], 0, 0, 0); __builtin_amdgcn_s_setprio(0); } while (0)
#define PG8_WAIT_V(n) asm volatile("s_waitcnt vmcnt(" #n ")" ::: "memory")
#define PG8_WAIT_L(n) asm volatile("s_waitcnt lgkmcnt(" #n ")" ::: "memory")
#define PG8_BAR __builtin_amdgcn_s_barrier()
#define PG8_SCHED __builtin_amdgcn_sched_barrier(0)
    Unit cur, nxt; int ui = 0;
    if (!S.next(0, cur)) return;
    f32x4 acc[2][2][4][2];
#pragma unroll
    for (int a = 0; a < 2; ++a)
#pragma unroll
        for (int b = 0; b < 2; ++b)
#pragma unroll
            for (int m = 0; m < 4; ++m)
#pragma unroll
                for (int n = 0; n < 2; ++n) acc[a][b][m][n] = (f32x4){0.f, 0.f, 0.f, 0.f};
    bf16x8 At[4][2], B0[2][2], B1[2][2];
    const char* cA = (const char*)g.A + (size_t)cur.pm * tstep; const char* cB = (const char*)g.Bt + (size_t)cur.pn * tstep;
    PG8_STAGE(PG8_SB(0, 0), cB, voffB); PG8_STAGE(PG8_SB(0, 1), cB + hstep, voffB); PG8_STAGE(PG8_SA(0, 0), cA, voffA); PG8_STAGE(PG8_SA(0, 1), cA + hstep, voffA);
    if (wr == 1) PG8_BAR;
    PG8_WAIT_V(2); PG8_BAR;
    PG8_STAGE(PG8_SB(1, 0), cB + kstep, voffB); PG8_STAGE(PG8_SA(1, 0), cA + kstep, voffA); PG8_STAGE(PG8_SB(1, 1), cB + hstep + kstep, voffB);
    PG8_WAIT_V(6); PG8_BAR;
    for (;;) {
        const bool has_next = S.next(ui + 1, nxt);
        const char* nA = has_next ? (const char*)g.A + (size_t)nxt.pm * tstep : cA; const char* nB = has_next ? (const char*)g.Bt + (size_t)nxt.pn * tstep : cB;
        for (int t = 0; t < nt; t += 2) {
            const bool last = (t == nt - 2);
            const char* a1 = cA + (size_t)(t + 1) * kstep;
            const char* a2 = last ? nA : cA + (size_t)(t + 2) * kstep; const char* b2 = last ? nB : cB + (size_t)(t + 2) * kstep;
            const char* a3 = a2 + kstep; const char* b3 = b2 + kstep;
            PG8_LDB(B0, 0, 0); PG8_LDB(B1, 0, 1); PG8_SCHED; PG8_LDA(At, 0, 0); PG8_STAGE(PG8_SA(1, 1), a1 + hstep, voffA);
            PG8_WAIT_V(8); PG8_WAIT_L(0); PG8_BAR; PG8_MMA(0, 0, At, B0); PG8_MMA(0, 1, At, B1); PG8_BAR; PG8_SCHED;
            PG8_LDA(At, 0, 1); PG8_STAGE(PG8_SB(0, 0), b2, voffB); PG8_STAGE(PG8_SB(0, 1), b2 + hstep, voffB); PG8_STAGE(PG8_SA(0, 0), a2, voffA);
            PG8_WAIT_V(8); PG8_WAIT_L(0); PG8_BAR; PG8_MMA(1, 0, At, B0); PG8_MMA(1, 1, At, B1); PG8_BAR; PG8_SCHED;
            PG8_LDB(B0, 1, 0); PG8_LDB(B1, 1, 1); PG8_SCHED; PG8_LDA(At, 1, 0); PG8_STAGE(PG8_SA(0, 1), a2 + hstep, voffA);
            PG8_WAIT_V(8); PG8_WAIT_L(0); PG8_BAR; PG8_MMA(0, 0, At, B0); PG8_MMA(0, 1, At, B1); PG8_BAR; PG8_SCHED;
            PG8_LDA(At, 1, 1); PG8_STAGE(PG8_SB(1, 0), b3, voffB); PG8_STAGE(PG8_SB(1, 1), b3 + hstep, voffB); PG8_STAGE(PG8_SA(1, 0), a3, voffA);
            PG8_WAIT_V(8); PG8_WAIT_L(0); PG8_BAR; PG8_MMA(1, 0, At, B0); PG8_MMA(1, 1, At, B1); PG8_BAR; PG8_SCHED;
        }
        if (wr == 0) PG8_BAR;
        if constexpr (Epi::NEEDS_RSTD) {
            if (tid < 256) ((LAS float*)(lds + RSTD_LDS))[tid] = row_rstd(E.rowsq, cur.pm * BM + tid);
            PG8_WAIT_L(0); PG8_BAR;
        }
        E(acc, cur, wr, wc, fr, fq, (const LAS float*)(lds + RSTD_LDS));
        if (!has_next) break;
#pragma unroll
        for (int a = 0; a < 2; ++a)
#pragma unroll
            for (int b = 0; b < 2; ++b)
#pragma unroll
                for (int m = 0; m < 4; ++m)
#pragma unroll
                    for (int n = 0; n < 2; ++n) acc[a][b][m][n] = (f32x4){0.f, 0.f, 0.f, 0.f};
        cur = nxt; cA = nA; cB = nB; ++ui;
        if (wr == 1) PG8_BAR;
    }
    PG8_WAIT_V(0);
    PG8_BAR;
#undef PG8_SA
#undef PG8_SB
#undef PG8_STAGE
#undef PG8_LDA
#undef PG8_LDB
#undef PG8_MMA
#undef PG8_WAIT_V
#undef PG8_WAIT_L
#undef PG8_BAR
#undef PG8_SCHED
}
}

__device__ __forceinline__ void transpose_item(const float* __restrict__ W, int K, int N, bf16_t* __restrict__ WT, const float* __restrict__ gain, int mode, LAS float* scr, int item, int lane) {
    (void)scr;
    const int nblk = N / 32, kb = item / nblk, nb = item % nblk, c = lane & 7, ng = lane >> 3, k0 = 64 * kb + 8 * c, n0 = 32 * nb + 4 * ng;
    f32x4 v[8];
#pragma unroll
    for (int j = 0; j < 8; ++j) v[j] = *(const f32x4*)(W + (size_t)(k0 + j) * N + n0);
    if (gain) { const f32x4 g0 = *(const f32x4*)(gain + k0), g1 = *(const f32x4*)(gain + k0 + 4);
#pragma unroll
        for (int j = 0; j < 4; ++j) { v[j] = v[j] * g0[j]; v[4 + j] = v[4 + j] * g1[j]; } }
#pragma unroll
    for (int i = 0; i < 4; ++i) { const int nn = n0 + i; const int drow = (mode == 0) ? nn : (256 * (nn >> 7) + (nn & 127) + (mode == 2 ? 128 : 0));
        u32x4 o; o.x = cvt_pk_bf16(v[0][i], v[1][i]); o.y = cvt_pk_bf16(v[2][i], v[3][i]); o.z = cvt_pk_bf16(v[4][i], v[5][i]); o.w = cvt_pk_bf16(v[6][i], v[7][i]);
        *(u32x4*)(WT + (size_t)drow * K + k0) = o; }
}
constexpr int IT_GU = (DM / 64) * (DFF / 32), IT_DN = (DFF / 64) * (DM / 32), IT_IN = (DM / 64) * (DIN / 32), IT_OUT = (DM / 64) * (DM / 32);
__device__ __forceinline__ void convert_part(const Args& a, int l, int part, LAS unsigned char* lds, int gw, int ngw, int wave, int lane) {
    LAS float* scr = (LAS float*)(lds + wave * 8448);
    bf16_t* wb = (bf16_t*)(a.ws + WS_W);
    if (part == 0) {
        constexpr int NIT = 3 * IT_GU + IT_IN;
        for (int it = gw; it < NIT; it += ngw) {
            int r = it;
            if (r < IT_GU) { transpose_item(a.in[2] + (size_t)l * DM * DFF, DM, DFF, wb + W_GU1, a.in[1] + l * DM, 1, scr, r, lane); continue; } r -= IT_GU;
            if (r < IT_GU) { transpose_item(a.in[3] + (size_t)l * DM * DFF, DM, DFF, wb + W_GU1, a.in[1] + l * DM, 2, scr, r, lane); continue; } r -= IT_GU;
            if (r < IT_DN) { transpose_item(a.in[4] + (size_t)l * DFF * DM, DFF, DM, wb + W_D1, nullptr, 0, scr, r, lane); continue; } r -= IT_DN;
            transpose_item(a.in[6] + (size_t)l * DM * DIN, DM, DIN, wb + W_IN, a.in[5] + l * DM, 0, scr, r, lane);
        }
    } else {
        constexpr int NIT = 3 * IT_GU + IT_OUT;
        for (int it = gw; it < NIT; it += ngw) {
            int r = it;
            if (r < IT_OUT) { transpose_item(a.in[16] + (size_t)l * DM * DM, DM, DM, wb + W_OUT, nullptr, 0, scr, r, lane); continue; } r -= IT_OUT;
            if (r < IT_GU) { transpose_item(a.in[18] + (size_t)l * DM * DFF, DM, DFF, wb + W_GU2, a.in[17] + l * DM, 1, scr, r, lane); continue; } r -= IT_GU;
            if (r < IT_GU) { transpose_item(a.in[19] + (size_t)l * DM * DFF, DM, DFF, wb + W_GU2, a.in[17] + l * DM, 2, scr, r, lane); continue; } r -= IT_GU;
            transpose_item(a.in[20] + (size_t)l * DFF * DM, DFF, DM, wb + W_D2, nullptr, 0, scr, r, lane);
        }
    }
}

__device__ __forceinline__ void p0_rows(const Args& a, int gw, int ngw, int lane) {
    const float* x = a.in[0]; bf16_t* xb = XB_PTR(a); float* rowsq = (float*)(a.ws + WS_ROWSQ); unsigned char* xlo = (unsigned char*)(a.ws + WS_XT);
    for (int m = gw; m < MTOK; m += ngw) {
        const f32x4* xr = (const f32x4*)(x + (size_t)m * DM) + lane;
        u32x2* brow = (u32x2*)(xb + (size_t)m * DM) + lane;
        const int pm = m >> 8, rr = m & 255, ai = rr >> 7, wr = (rr >> 6) & 1, mm = (rr >> 4) & 3, fr = rr & 15;
        float s = 0.f;
#pragma unroll
        for (int j = 0; j < 4; ++j) { const f32x4 v = xr[64 * j]; s += (v[0] * v[0] + v[1] * v[1]) + (v[2] * v[2] + v[3] * v[3]);
            const int c = 4 * lane + 256 * j, pn = c >> 8, cc = c & 255, bj = cc >> 7, wc = (cc >> 5) & 3, fq = (cc >> 3) & 3, hf = (cc >> 2) & 1;
            const unsigned b0 = pg8::res_enc(v[0]), b1 = pg8::res_enc(v[1]), b2 = pg8::res_enc(v[2]), b3 = pg8::res_enc(v[3]);
            u32x2 h; h.x = (pg8::res_hi(b0) & 0xffffu) | (pg8::res_hi(b1) << 16); h.y = (pg8::res_hi(b2) & 0xffffu) | (pg8::res_hi(b3) << 16);
            brow[64 * j] = h;
            unsigned char* lpp = xlo + pg8::lo_off(pm, pn, wr * 4 + wc, ai, mm, bj, fq * 16 + fr) + (pg8::LOB / 2) * hf;
            if (pg8::LOB == 8) *(unsigned*)lpp = (b0 & 0xffu) | ((b1 & 0xffu) << 8) | ((b2 & 0xffu) << 16) | (b3 << 24);
            else *(unsigned short*)lpp = (unsigned short)((b0 & 0xfu) | ((b1 & 0xfu) << 4) | ((b2 & 0xfu) << 8) | ((b3 & 0xfu) << 12)); }
        s = wave_sum(s);
        if (lane < 16) rowsq[(size_t)m * 16 + lane] = lane == 0 ? s : 0.f;
    }
}

constexpr int LRU_NITEMS = NBATCH * 12 * 32;
template <bool FINAL>
__device__ __forceinline__ void lru_phase(LAS unsigned char* lds, const Args& a, int l, int blk, int G, int wave, int lane) {
    const bf16_t* proj = (const bf16_t*)(a.ws + WS_BIG); bf16_t* mix = MIX_PTR(a); float* summ = (float*)(a.ws + WS_SUMM);
    LAS unsigned char* wl = lds + wave * 11264;
    LAS bf16_t* XC = (LAS bf16_t*)wl;
    LAS float* PRE = (LAS float*)(wl + 2304);
    LAS float* SEG = (LAS float*)(lds + 8 * 11264);
    LAS float* CARRY = SEG + 2048;
    const int fr = lane & 15, fq = lane >> 4;
    const int per = (LRU_NITEMS + G - 1) / G, it0 = blk * per, it1 = (it0 + per < LRU_NITEMS) ? it0 + per : LRU_NITEMS;
    int cur_seq = -1;
    bf16x8 Bf[2][4][2]; float cw0 = 0, cw1 = 0, cw2 = 0, cw3 = 0, cb = 0, ba = 0, bx = 0, sp = 0, ba2 = 0, bx2 = 0, c2 = 0;
    unsigned short xr[19], gr[16];
#define LRU_LOAD(itn) do { const int seq_ = (itn) >> 5, chunk_ = (itn) & 31, b_ = seq_ / 12, hb_ = seq_ - b_ * 12, t0_ = chunk_ * 128 + 16 * wave; \
        const bf16_t* xp_ = proj + (size_t)b_ * SEQ * DIN + LXOFF + hb_ * 64 + lane; \
        _Pragma("unroll") for (int i = 0; i < 19; ++i) { const int t = t0_ - 3 + i; xr[i] = xp_[(size_t)(t < 0 ? 0 : t) * DIN]; } \
        if (FINAL) { const bf16_t* gp_ = xp_ + (LGOFF - LXOFF); _Pragma("unroll") for (int i = 0; i < 16; ++i) gr[i] = gp_[(size_t)(t0_ + i) * DIN]; } } while (0)
    if (it0 < it1) LRU_LOAD(it0);
    for (int it = it0; it < it1; ++it) {
        const int seq = it >> 5, chunk = it & 31, b = seq / 12, hb = seq - b * 12;
        if (seq != cur_seq) {
            cur_seq = seq;
            const int ch = hb * 64 + lane;
            cw0 = a.in[9][(l * 4 + 0) * DLRU + ch]; cw1 = a.in[9][(l * 4 + 1) * DLRU + ch]; cw2 = a.in[9][(l * 4 + 2) * DLRU + ch]; cw3 = a.in[9][(l * 4 + 3) * DLRU + ch];
            cb = a.in[10][l * DLRU + ch]; ba = a.in[12][l * DLRU + ch]; bx = a.in[14][l * DLRU + ch];
            sp = log1pf(expf(-a.in[15][l * DLRU + ch]));
            ba2 = -ba * LOG2E; bx2 = -bx * LOG2E; c2 = -8.0f * sp * LOG2E;
#pragma unroll
            for (int gg = 0; gg < 2; ++gg) { const float* Wg = a.in[gg ? 13 : 11] + ((size_t)(l * 12 + hb)) * 4096;
#pragma unroll
                for (int nt = 0; nt < 4; ++nt)
#pragma unroll
                    for (int ks = 0; ks < 2; ++ks) { float wv[8];
#pragma unroll
                        for (int jj = 0; jj < 8; ++jj) wv[jj] = Wg[(32 * ks + 8 * fq + jj) * 64 + 16 * nt + fr];
                        u32x4 w; w.x = cvt_pk_bf16(wv[0], wv[1]); w.y = cvt_pk_bf16(wv[2], wv[3]); w.z = cvt_pk_bf16(wv[4], wv[5]); w.w = cvt_pk_bf16(wv[6], wv[7]);
                        Bf[gg][nt][ks] = __builtin_bit_cast(bf16x8, w); } }
            if (FINAL) {
                __syncthreads();
                { const float* sp_ = summ + (size_t)seq * 32 * 128 + lane; float av[4], bv[4];
#pragma unroll
                  for (int k = 0; k < 4; ++k) { const int cc = 4 * wave + k; const float A = sp_[cc * 128], B = sp_[cc * 128 + 64]; av[k] = cc < chunk ? A : 1.f; bv[k] = cc < chunk ? B : 0.f; }
                  float A = 1.f, B = 0.f;
#pragma unroll
                  for (int k = 0; k < 4; ++k) { B = av[k] * B + bv[k]; A *= av[k]; }
                  SEG[(wave * 2 + 0) * 64 + lane] = A; SEG[(wave * 2 + 1) * 64 + lane] = B; }
                __syncthreads();
                if (wave == 0) { float h = 0.f;
#pragma unroll
                    for (int s2 = 0; s2 < 8; ++s2) h = SEG[(s2 * 2) * 64 + lane] * h + SEG[(s2 * 2 + 1) * 64 + lane];
                    CARRY[(it & 1) * 64 + lane] = h; }
                __syncthreads();
            }
        }
        const int t0 = chunk * 128 + 16 * wave;
        float xv[19];
#pragma unroll
        for (int i = 0; i < 19; ++i) xv[i] = (t0 - 3 + i) < 0 ? 0.f : bf2f(xr[i]);
        float gv[16];
        if (FINAL) {
#pragma unroll
            for (int i = 0; i < 16; ++i) gv[i] = bf2f(gr[i]);
        }
        if (it + 1 < it1) LRU_LOAD(it + 1);
        float xc[16];
#pragma unroll
        for (int i = 0; i < 16; ++i) { xc[i] = cb + cw0 * xv[i] + cw1 * xv[i + 1] + cw2 * xv[i + 2] + cw3 * xv[i + 3]; XC[i * 72 + lane] = (bf16_t)(cvt_pk_bf16(xc[i], 0.f) & 0xffffu); }
        LDS_WAIT();
        bf16x8 af[2];
#pragma unroll
        for (int ks = 0; ks < 2; ++ks) af[ks] = *(const LAS bf16x8*)((const LAS unsigned char*)XC + fr * 144 + fq * 16 + ks * 64);
#pragma unroll
        for (int gg = 0; gg < 2; ++gg)
#pragma unroll
            for (int nt = 0; nt < 4; ++nt) { f32x4 c = (f32x4){0.f, 0.f, 0.f, 0.f};
#pragma unroll
                for (int ks = 0; ks < 2; ++ks) c = __builtin_amdgcn_mfma_f32_16x16x32_bf16(af[ks], Bf[gg][nt][ks], c, 0, 0, 0);
#pragma unroll
                for (int rg = 0; rg < 4; ++rg) PRE[gg * 16 * 68 + (4 * fq + rg) * 68 + 16 * nt + fr] = c[rg]; }
        LDS_WAIT();
        float h = 0.f, P = 1.f; float hl[16], Pl[16];
#pragma unroll
        for (int i = 0; i < 16; ++i) {
            const float r = fast_rcp(1.0f + __builtin_amdgcn_exp2f(__builtin_fmaf(PRE[i * 68 + lane], -LOG2E, ba2)));
            const float ig = fast_rcp(1.0f + __builtin_amdgcn_exp2f(__builtin_fmaf(PRE[16 * 68 + i * 68 + lane], -LOG2E, bx2)));
            const float aa = __builtin_amdgcn_exp2f(r * c2);
            const float bb = __builtin_sqrtf(fmaxf(1.0f - aa * aa, 0.f)) * ig * xc[i];
            h = aa * h + bb; P *= aa; hl[i] = h; Pl[i] = P;
        }
        LAS float* SEGk = SEG + (it & 1) * 1024;
        SEGk[(wave * 2 + 0) * 64 + lane] = P; SEGk[(wave * 2 + 1) * 64 + lane] = h;
        __syncthreads();
        if (FINAL) {
            float hin = CARRY[(it & 1) * 64 + lane];
            for (int s = 0; s < wave; ++s) hin = SEGk[(s * 2) * 64 + lane] * hin + SEGk[(s * 2 + 1) * 64 + lane];
            if (wave == 7) CARRY[((it + 1) & 1) * 64 + lane] = P * hin + h;
            bf16_t* yp = mix + ((size_t)b * SEQ + t0) * DM + 256 + hb * 64 + lane;
#pragma unroll
            for (int i = 0; i < 16; ++i) { const float hv = hl[i] + Pl[i] * hin; const float g = gv[i];
                const float w2 = g * __builtin_fmaf(g * g, -1.5957691216f * 0.044715f * LOG2E, -1.5957691216f * LOG2E);
                const float y = hv * g * fast_rcp(1.0f + __builtin_amdgcn_exp2f(w2));
                yp[(size_t)i * DM] = (bf16_t)(cvt_pk_bf16(y, 0.f) & 0xffffu); }
        } else {
            if (wave == 0) { float A = 1.f, B = 0.f;
#pragma unroll
                for (int s = 0; s < 8; ++s) { const float As = SEGk[(s * 2) * 64 + lane], Bs = SEGk[(s * 2 + 1) * 64 + lane]; B = As * B + Bs; A *= As; }
                float* sp_ = summ + ((size_t)seq * 32 + chunk) * 128 + lane; sp_[0] = A; sp_[64] = B; }
        }
    }
#undef LRU_LOAD
    __syncthreads();
}

__device__ __forceinline__ float sumsq8(bf16x8 v) { const u32x4 w = __builtin_bit_cast(u32x4, v); float s = 0.f;
#pragma unroll
    for (int i = 0; i < 4; ++i) { const float lo = bflo(w[i]), hi = bfhi(w[i]); s += lo * lo + hi * hi; } return s; }
__device__ __forceinline__ s16x4 vtr(const LAS unsigned char* p) { typedef short v4i16_t __attribute__((ext_vector_type(4))); return __builtin_amdgcn_ds_read_tr16_b64_v4i16((LAS v4i16_t*)p); }

struct AttJob { const bf16_t* base; int rsh, rho, i0, koff, voff, qoff; };
constexpr int ATT_NITEMS = NBATCH * 4 * (SEQ / 256);
__device__ __forceinline__ AttJob att_make_job(const bf16_t* proj, int it, int jidx, int wave) {
    const int tile = it & 15, hs = (it >> 4) & 3, b = it >> 6, g = jidx >> 1, jb = jidx & 1;
    AttJob J; J.rsh = 2 * g; const int r = 1 << J.rsh, j = 2 * wave + jb; J.rho = j & (r - 1); const int sub = j >> J.rsh;
    J.i0 = ((tile * 256) >> J.rsh) + 16 * sub; J.base = proj + (size_t)b * SEQ * DIN;
    J.qoff = QOFF + g * 256 + hs * 64; J.koff = KOFF + g * 256 + hs * 64; J.voff = VOFF + g * 256 + hs * 64; return J;
}
__device__ __forceinline__ void attn_phase(LAS unsigned char* lds, const Args& a, int l, int vcu, int G, int wave, int lane) {
    const bf16_t* proj = (const bf16_t*)(a.ws + WS_BIG); bf16_t* mix = MIX_PTR(a);
    LAS float* O = (LAS float*)lds;
    LAS float* Z = (LAS float*)(lds + 256 * 68 * 4);
    LAS unsigned char* Vst = lds + 256 * 68 * 4 + 1024 + wave * 4608;
    const int fr = lane & 15, fq = lane >> 4, tid = wave * 64 + lane;
    const float* gq = a.in[7] + l * 64; const float* gk = a.in[8] + l * 64;
    const float mshift = 8.0f * wave_max(fabsf(gq[lane])) * wave_max(fabsf(gk[lane])) * LOG2E;
    LAS float* GQK = (LAS float*)(lds + 256 * 68 * 4 + 1024 + 8 * 4608);
    if (wave == 0) GQK[lane] = gq[lane] * gk[lane] * (0.125f * LOG2E);
    __syncthreads();
    if (vcu >= ATT_NITEMS) return;
    bf16x8 kf[5][2][2], vv[5][4], qn[2];
#define ATT_ISSUE_K(buf, J, p) do { \
        _Pragma("unroll") for (int aa = ((p) == 0 ? 1 : 0); aa < 2; ++aa) { const int ik = (J).i0 - 144 + 32 * (p) + 16 * aa + fr; const int ikc = ik < 0 ? 0 : ik; \
            const bf16_t* kp = (J).base + (size_t)((J).rho + (ikc << (J).rsh)) * DIN + (J).koff + 8 * fq; \
            kf[buf][aa][0] = *(const bf16x8*)kp; kf[buf][aa][1] = *(const bf16x8*)(kp + 32); } } while (0)
#define ATT_ISSUE_V(buf, J, p) do { \
        _Pragma("unroll") for (int i = 0; i < 4; ++i) { const int idx = lane + 64 * i, kk = idx >> 3, ch = idx & 7; const int ik = (J).i0 - 144 + 32 * (p) + kk; const int ikc = ik < 0 ? 0 : ik; \
            vv[buf][i] = *(const bf16x8*)((J).base + (size_t)((J).rho + (ikc << (J).rsh)) * DIN + (J).voff + 8 * ch); } } while (0)
#define ATT_ISSUE_Q(J) do { const bf16_t* qp = (J).base + (size_t)((J).rho + (((J).i0 + fr) << (J).rsh)) * DIN + (J).qoff + 8 * fq; qn[0] = *(const bf16x8*)qp; qn[1] = *(const bf16x8*)(qp + 32); } while (0)
    AttJob Jc = att_make_job(proj, vcu, 0, wave);
    ATT_ISSUE_Q(Jc); ATT_ISSUE_K(0, Jc, 0); ATT_ISSUE_V(0, Jc, 0); ATT_ISSUE_K(1, Jc, 1); ATT_ISSUE_K(2, Jc, 2);
    for (int it = vcu; it < ATT_NITEMS; it += G) {
        const int tile = it & 15, hs = (it >> 4) & 3, b = it >> 6, t0 = tile * 256;
        for (int jidx = 0; jidx < 6; ++jidx) {
            const int g = jidx >> 1;
            const bool has_next = (jidx < 5) || (it + G < ATT_NITEMS);
            const AttJob Jn = att_make_job(proj, (jidx < 5 || !has_next) ? it : it + G, jidx < 5 ? jidx + 1 : (has_next ? 0 : 5), wave);
            const float slope2 = exp2f(-8.0f * (float)(4 * g + hs + 1) / 12.0f) * (float)(1 << Jc.rsh) * LOG2E;
            bf16x8 qf[2];
            {
                const bf16x8 q0 = qn[0], q1 = qn[1];
                float ss = sumsq8(q0) + sumsq8(q1); ss += __shfl_xor(ss, 16); ss += __shfl_xor(ss, 32);
                const float rq = __builtin_amdgcn_rsqf(ss * (1.0f / 64.0f) + RMS_EPS);
                const u32x4 w0 = __builtin_bit_cast(u32x4, q0), w1 = __builtin_bit_cast(u32x4, q1); u32x4 o0, o1;
                const LAS f32x4* gp = (const LAS f32x4*)(GQK + 8 * fq);
                const f32x4 ga = gp[0] * rq, gb = gp[1] * rq, gc = gp[8] * rq, gd = gp[9] * rq;
                o0[0] = cvt_pk_bf16(bflo(w0[0]) * ga[0], bfhi(w0[0]) * ga[1]); o0[1] = cvt_pk_bf16(bflo(w0[1]) * ga[2], bfhi(w0[1]) * ga[3]);
                o0[2] = cvt_pk_bf16(bflo(w0[2]) * gb[0], bfhi(w0[2]) * gb[1]); o0[3] = cvt_pk_bf16(bflo(w0[3]) * gb[2], bfhi(w0[3]) * gb[3]);
                o1[0] = cvt_pk_bf16(bflo(w1[0]) * gc[0], bfhi(w1[0]) * gc[1]); o1[1] = cvt_pk_bf16(bflo(w1[1]) * gc[2], bfhi(w1[1]) * gc[3]);
                o1[2] = cvt_pk_bf16(bflo(w1[2]) * gd[0], bfhi(w1[2]) * gd[1]); o1[3] = cvt_pk_bf16(bflo(w1[3]) * gd[2], bfhi(w1[3]) * gd[3]);
                qf[0] = __builtin_bit_cast(bf16x8, o0); qf[1] = __builtin_bit_cast(bf16x8, o1);
            }
            f32x4 oacc[4];
#pragma unroll
            for (int dt = 0; dt < 4; ++dt) oacc[dt] = (f32x4){0.f, 0.f, 0.f, 0.f};
            float zsum = 0.f;
            const float laneb = -slope2 * (float)(fr - 4 * fq) - mshift;
#pragma unroll
            for (int p = 0; p < 5; ++p) {
                if (p + 3 < 5) { ATT_ISSUE_K(p + 3, Jc, p + 3); } else { ATT_ISSUE_K((p + 3) % 5, Jn, p + 3 - 5); }
                if (p + 1 < 5) { ATT_ISSUE_V(p + 1, Jc, p + 1); } else { ATT_ISSUE_V(0, Jn, 0); }
                if (p == 4) ATT_ISSUE_Q(Jn);
                const int ikb = Jc.i0 - 144 + 32 * p;
                float pv[2][4];
#pragma unroll
                for (int aa = 0; aa < 2; ++aa) {
                    if (p == 0 && aa == 0) { pv[0][0] = 0.f; pv[0][1] = 0.f; pv[0][2] = 0.f; pv[0][3] = 0.f; continue; }
                    const bf16x8 k0 = kf[p][aa][0], k1 = kf[p][aa][1];
                    f32x4 sc = (f32x4){0.f, 0.f, 0.f, 0.f};
                    sc = __builtin_amdgcn_mfma_f32_16x16x32_bf16(k0, qf[0], sc, 0, 0, 0);
                    sc = __builtin_amdgcn_mfma_f32_16x16x32_bf16(k1, qf[1], sc, 0, 0, 0);
                    f32x4 kk2 = (f32x4){0.f, 0.f, 0.f, 0.f};
                    kk2 = __builtin_amdgcn_mfma_f32_16x16x32_bf16(k0, k0, kk2, 0, 0, 0);
                    kk2 = __builtin_amdgcn_mfma_f32_16x16x32_bf16(k1, k1, kk2, 0, 0, 0);
                    const int base = 144 - 32 * p - 16 * aa;
                    const bool chk_hi = (p == 0 && aa == 1), chk_lo = (p == 4 && aa == 1);
#pragma unroll
                    for (int rg = 0; rg < 4; ++rg) {
                        const float rkk = __builtin_amdgcn_rsqf(__shfl(kk2[rg], 20 * fq + rg) * (1.0f / 64.0f) + RMS_EPS);
                        const int ik = ikb + 16 * aa + 4 * fq + rg;
                        bool valid = (ik >= 0);
                        if (chk_hi) valid = valid && (fr - 4 * fq - rg + base <= 128);
                        if (chk_lo) valid = valid && (fr - 4 * fq - rg + base >= 0);
                        const float e = __builtin_fmaf(sc[rg], rkk, __builtin_fmaf(-slope2, (float)(base - rg), laneb));
                        const float pe = valid ? __builtin_amdgcn_exp2f(e) : 0.f;
                        pv[aa][rg] = pe; zsum += pe;
                    }
                }
                u32x4 pw; pw.x = cvt_pk_bf16(pv[0][0], pv[0][1]); pw.y = cvt_pk_bf16(pv[0][2], pv[0][3]); pw.z = cvt_pk_bf16(pv[1][0], pv[1][1]); pw.w = cvt_pk_bf16(pv[1][2], pv[1][3]);
                const bf16x8 pb = __builtin_bit_cast(bf16x8, pw);
#pragma unroll
                for (int i = 0; i < 4; ++i) { const int idx = lane + 64 * i, kk = idx >> 3, ch = idx & 7; *(LAS bf16x8*)(Vst + kk * 144 + ch * 16) = vv[p][i]; }
                LDS_WAIT();
                const LAS unsigned char* vb = Vst + (4 * fq + (fr >> 2)) * 144 + (fr & 3) * 8;
#pragma unroll
                for (int dt = 0; dt < 4; ++dt) {
                    const s16x4 lo = vtr(vb + dt * 32), hi = vtr(vb + 16 * 144 + dt * 32);
                    const bf16x8 va = (bf16x8){lo[0], lo[1], lo[2], lo[3], hi[0], hi[1], hi[2], hi[3]};
                    oacc[dt] = __builtin_amdgcn_mfma_f32_16x16x32_bf16(va, pb, oacc[dt], 0, 0, 0);
                }
                LDS_WAIT();
                asm volatile("" ::: "memory");
            }
            zsum += __shfl_xor(zsum, 16); zsum += __shfl_xor(zsum, 32);
            const int tl = Jc.rho + (((Jc.i0 - (t0 >> Jc.rsh)) + fr) << Jc.rsh);
            LAS f32x4* op = (LAS f32x4*)(O + tl * 68 + 4 * fq);
            if (g == 0) {
#pragma unroll
                for (int dt = 0; dt < 4; ++dt) op[4 * dt] = oacc[dt];
                if (fq == 0) Z[tl] = zsum;
            } else {
#pragma unroll
                for (int dt = 0; dt < 4; ++dt) { const f32x4 o = op[4 * dt]; op[4 * dt] = o + oacc[dt]; }
                if (fq == 0) Z[tl] += zsum;
            }
            Jc = Jn;
            if (jidx & 1) __syncthreads();
        }
        {
            const int tok = tid >> 1, half = tid & 1;
            const float inv = 1.0f / Z[tok];
            const LAS f32x4* op = (const LAS f32x4*)(O + tok * 68 + 32 * half);
            bf16_t* dst = mix + ((size_t)b * SEQ + t0 + tok) * DM + hs * 64 + 32 * half;
#pragma unroll
            for (int i = 0; i < 4; ++i) { const f32x4 v0 = op[2 * i] * inv, v1 = op[2 * i + 1] * inv;
                u32x4 w; w.x = cvt_pk_bf16(v0[0], v0[1]); w.y = cvt_pk_bf16(v0[2], v0[3]); w.z = cvt_pk_bf16(v1[0], v1[1]); w.w = cvt_pk_bf16(v1[2], v1[3]);
                *(u32x4*)(dst + 8 * i) = w; }
        }
        __syncthreads();
    }
#undef ATT_ISSUE_K
#undef ATT_ISSUE_V
#undef ATT_ISSUE_Q
}


constexpr size_t WS_CTL = 3 * MiB + 512 * 1024;
constexpr int CTL_BYTES = 16384;
constexpr int LDS_MISC = 140000;
#define XB_TMO      128
#define XB_XCNT(j)  (256  + 64 * (j))
#define XB_XSUB(j)  (1280 + 64 * (j))
#define XB_XGEN(j)  (2304 + 64 * (j))
#define XB_TOP      3328
#define XB_TOPGEN   3392
#define XB_SPIN_CAP (1u << 18)
__device__ __forceinline__ unsigned xb_ld(unsigned* p)              { return __hip_atomic_load(p, __ATOMIC_RELAXED, __HIP_MEMORY_SCOPE_AGENT); }
__device__ __forceinline__ unsigned xb_add(unsigned* p, unsigned v) { return __hip_atomic_fetch_add(p, v, __ATOMIC_RELAXED, __HIP_MEMORY_SCOPE_AGENT); }
__device__ __forceinline__ unsigned xb_xcc_id() { return (unsigned)__builtin_amdgcn_s_getreg((3 << 11) | 20) & 0xFu; }
#define XB_SPIN(cond, bar) do { unsigned _sp = 0; while (cond) { __builtin_amdgcn_s_sleep(1); \
    if ((++_sp & 255u) == 0u) { if (xb_ld(&(bar)[XB_TMO])) break; if (_sp > XB_SPIN_CAP) { atomicAdd(&(bar)[XB_TMO], 1u); break; } } } } while (0)
__device__ __forceinline__ void xcd_barrier_complete(unsigned* bar, unsigned x, unsigned& nloc, unsigned& nx) {
    const unsigned G = gridDim.x * gridDim.y * gridDim.z;
    unsigned sum, cnt, mine, sp = 0u;
    for (;;) {
        sum = 0u; cnt = 0u; mine = 0u;
#pragma unroll
        for (unsigned j = 0; j < 16; ++j) { const unsigned c = xb_ld(&bar[XB_XCNT(j)]); sum += c; cnt += (c > 0u) ? 1u : 0u; mine = (j == x) ? c : mine; }
        if (sum == G) break;
        __builtin_amdgcn_s_sleep(1);
        if ((++sp & 255u) == 0u) { if (xb_ld(&bar[XB_TMO])) break; if (sp > XB_SPIN_CAP) { atomicAdd(&bar[XB_TMO], 1u); break; } }
    }
    nloc = mine > 0u ? mine : 1u; nx = cnt > 0u ? cnt : 1u;
}
__device__ __forceinline__ void xcd_barrier(unsigned* bar, volatile LAS unsigned* st) {
    asm volatile("s_waitcnt vmcnt(0)" ::: "memory");
    __syncthreads();
    if (threadIdx.x == 0) {
        __builtin_amdgcn_s_waitcnt(0);
        const unsigned x = xb_xcc_id();
        unsigned nloc = st[0], nx = st[1];
        if (nloc == 0u) { xcd_barrier_complete(bar, x, nloc, nx); st[0] = nloc; st[1] = nx; }
        const unsigned old = xb_add(&bar[XB_XSUB(x)], 1u);
        const unsigned gen = old / nloc;
        if (old + 1u == (gen + 1u) * nloc) {
            __builtin_amdgcn_fence(__ATOMIC_RELEASE, "agent");
            asm volatile("s_waitcnt vmcnt(0)" ::: "memory");
            const unsigned og = xb_add(&bar[XB_TOP], 1u);
            const unsigned tg = og / nx;
            if (og + 1u == (tg + 1u) * nx) xb_add(&bar[XB_TOPGEN], 1u);
            else XB_SPIN(xb_ld(&bar[XB_TOPGEN]) == tg, bar);
            __builtin_amdgcn_fence(__ATOMIC_ACQUIRE, "agent");
            xb_add(&bar[XB_XGEN(x)], 1u);
            asm volatile("s_waitcnt vmcnt(0)" ::: "memory");
        } else {
            XB_SPIN(xb_ld(&bar[XB_XGEN(x)]) == gen, bar);
            __builtin_amdgcn_fence(__ATOMIC_ACQUIRE, "agent");
            asm volatile("s_waitcnt vmcnt(0)" ::: "memory");
        }
    }
    __syncthreads();
}

__global__ void __launch_bounds__(512, 2) trunk_fwd(Args a) {
    extern __shared__ __attribute__((aligned(16))) unsigned char lds_raw[];
    LAS unsigned char* lds = (LAS unsigned char*)lds_raw;
    cg::grid_group grid = cg::this_grid();
    unsigned* barw = (unsigned*)(a.ws + WS_CTL);
    volatile LAS unsigned* bst = (volatile LAS unsigned*)(lds + LDS_MISC);
    if (threadIdx.x == 0) { bst[0] = 0u; bst[1] = 0u; if (a.ph_hi - a.ph_lo > 1) (void)xb_add(&barw[XB_XCNT(xb_xcc_id())], 1u); }
    __syncthreads();
    bool redo = false; int nseam = 0;
    for (int ph = a.ph_lo; ph < a.ph_hi; ++ph) {
        if (a.ph_lo < 0) grid.sync();
        if (nseam >= 1) xcd_barrier(barw, bst);
        ++nseam;

        int tid = threadIdx.x; asm volatile("" : "+v"(tid));
        int G = gridDim.x, blk = blockIdx.x; asm volatile("" : "+s"(G), "+s"(blk));
        unsigned char* wsb = a.ws; asm volatile("" : "+s"(wsb));
        const int lane = tid & 63, wave = __builtin_amdgcn_readfirstlane(tid >> 6);
        const int gw = blk * 8 + wave, ngw = G * 8;
        bf16_t* wb = (bf16_t*)(wsb + WS_W); bf16_t* xb = XB_PTR(a); bf16_t* mixb = MIX_PTR(a); bf16_t* big = (bf16_t*)(wsb + WS_BIG);
        float* rowsq = (float*)(wsb + WS_ROWSQ);
        if (ph == 0) { p0_rows(a, gw, ngw, lane); convert_part(a, 0, 0, lds, gw, ngw, wave, lane); continue; }
        const int l = (ph - 1) >> 3, s = (ph - 1) & 7;
        if (s == 0 || s == 6) {
            pg8::Gemm g{xb, wb + (s == 0 ? W_GU1 : W_GU2), MTOK, 2 * DFF, DM}; pg8::StaticOrderT<2 * DFF / 256> S; S.init(G, blk);
            pg8::EpiSwiGLU E{big, rowsq};
            pg8::gemm_phase<pg8::EpiSwiGLU, pg8::StaticOrderT<2 * DFF / 256>>(lds, g, S, E, tid);
        } else if (s == 1 || s == 7 || s == 5) {
            const bool isout = (s == 5);
            pg8::Gemm g{isout ? mixb : big, wb + (s == 1 ? W_D1 : (s == 7 ? W_D2 : W_OUT)), MTOK, DM, isout ? DM : DFF}; pg8::StaticOrderT<DM / 256> S; S.init(G, blk);
            pg8::EpiResid E{(unsigned char*)(wsb + WS_XT), xb, rowsq, isout ? 1.0f : 0.5f, nullptr, (ph == NPH - 1) ? a.out : nullptr};
            pg8::gemm_phase<pg8::EpiResid, pg8::StaticOrderT<DM / 256>>(lds, g, S, E, tid);
        } else if (s == 2) {
            pg8::Gemm g{xb, wb + W_IN, MTOK, DIN, DM}; pg8::StaticOrderT<DIN / 256> S; S.init(G, blk);
            pg8::EpiProj E{big, DIN, rowsq};
            pg8::gemm_phase<pg8::EpiProj, pg8::StaticOrderT<DIN / 256>>(lds, g, S, E, tid);
            { const int nun = (MTOK / 256) * (DIN / 256), nx = nun - (nun / G) * G;
              if (nx > 0 && blk >= nx) convert_part(a, l, 1, lds, (blk - nx) * 8 + wave, (G - nx) * 8, wave, lane); }
        } else if (s == 3) {
            for (int rep = 0; rep <= DUP_CONV; ++rep) {
            { const int nun = (MTOK / 256) * (DIN / 256); if (nun % G == 0) convert_part(a, l, 1, lds, gw, ngw, wave, lane); }
            if (l + 1 < DEPTH) convert_part(a, l + 1, 0, lds, gw, ngw, wave, lane);
            __syncthreads(); }
            for (int rep = 0; rep <= DUP_LRU1; ++rep) lru_phase<false>(lds, a, l, blk, G, wave, lane);
            for (int rep = 0; rep <= DUP_ATT; ++rep)
            { const int vcu = (G % 8 == 0) ? (blk % 8) * (G / 8) + blk / 8 : blk;
              attn_phase(lds, a, l, vcu, G, wave, lane); }
        } else {
            for (int rep = 0; rep <= DUP_LRU2; ++rep) lru_phase<true>(lds, a, l, blk, G, wave, lane);
        }
        if (DUP_SMASK) { if (!redo && ((DUP_SMASK >> s) & 1)) { redo = true; --ph; } else redo = false; }
    }
}

extern "C" void kernel_launch(void* const* d_in, const int* in_sizes, int n_in, void* d_out, int out_size, void* d_ws, size_t ws_size, hipStream_t stream) {
    static int grid = 0;
    if (grid == 0) {
        if (n_in != 21 || in_sizes[0] != MTOK * DM || out_size != MTOK * DM || ws_size < WS_END) { fprintf(stderr, "kernel_launch: unexpected shapes (n_in %d, in0 %d, out %d, ws %zu)\n", n_in, n_in > 0 ? in_sizes[0] : -1, out_size, ws_size); grid = -1; return; }
        int dev = 0, cus = 0, per_cu = 0;
        (void)hipGetDevice(&dev); (void)hipDeviceGetAttribute(&cus, hipDeviceAttributeMultiprocessorCount, dev);
        if (hipFuncSetAttribute((const void*)trunk_fwd, hipFuncAttributeMaxDynamicSharedMemorySize, LDS_BYTES) != hipSuccess) { fprintf(stderr, "kernel_launch: hipFuncSetAttribute failed\n"); grid = -1; return; }
        (void)hipOccupancyMaxActiveBlocksPerMultiprocessor(&per_cu, (const void*)trunk_fwd, 512, LDS_BYTES);
        (void)hipGetLastError();
        if (per_cu < 1) { fprintf(stderr, "kernel_launch: occupancy query says %d blocks/CU\n", per_cu); per_cu = 1; }
        grid = cus;
    }
    if (grid < 0) return;
    Args a{};
    for (int i = 0; i < 21; ++i) a.in[i] = (const float*)d_in[i];
    a.out = (float*)d_out; a.ws = (unsigned char*)d_ws;
#if MK_ONE_LAUNCH
    a.ph_lo = 0; a.ph_hi = NPH;
    void* args[] = {&a};
    if (hipMemsetAsync((char*)d_ws + WS_CTL, 0, CTL_BYTES, stream) != hipSuccess) { fprintf(stderr, "kernel_launch: memset of the barrier words failed\n"); return; }
    hipError_t e = hipLaunchCooperativeKernel((const void*)trunk_fwd, dim3(grid), dim3(512), args, LDS_BYTES, stream);
    if (e != hipSuccess) fprintf(stderr, "cooperative launch failed: %s (grid %d)\n", hipGetErrorString(e), grid);
#else
    for (int ph = 0; ph < NPH; ++ph) {
        a.ph_lo = ph; a.ph_hi = ph + 1;
        hipLaunchKernelGGL(trunk_fwd, dim3(grid), dim3(512), LDS_BYTES, stream, a);
    }
#endif
}
```

```cpp
#include <hip/hip_runtime.h>
#include <hip/hip_cooperative_groups.h>
#include <cstdio>
#include <cstdint>
namespace cg = cooperative_groups;

#ifndef MK_ONE_LAUNCH
#define MK_ONE_LAUNCH 1
#endif
#define DUP_UP 0
#define DUP_SMASK 0
#define DUP_IN 0
#define DUP_CONV 0
#define DUP_LRU1 0
#define DUP_ATT 0
#define DUP_LRU2 0

#define LAS __attribute__((address_space(3)))
typedef unsigned short bf16_t;
typedef short bf16x8 __attribute__((ext_vector_type(8)));
typedef short s16x4 __attribute__((ext_vector_type(4)));
typedef float f32x4 __attribute__((ext_vector_type(4)));
typedef float f32x2 __attribute__((ext_vector_type(2)));
typedef unsigned u32x4 __attribute__((ext_vector_type(4)));
typedef unsigned u32x2 __attribute__((ext_vector_type(2)));

constexpr int DM = 1024, NBATCH = 8, SEQ = 4096, DEPTH = 4, MTOK = NBATCH * SEQ;
constexpr int DFF = 2816, DIN = 3840, DLRU = 768;
constexpr int QOFF = 0, KOFF = 768, VOFF = 1536, LXOFF = 2304, LGOFF = 3072;
constexpr float RMS_EPS = 1e-6f, LOG2E = 1.4426950408889634f;
constexpr int NPH = 1 + 8 * DEPTH;

constexpr size_t MiB = 1u << 20;
constexpr size_t WS_ROWSQ = 0;
constexpr size_t WS_SUMM = 2 * MiB;
constexpr size_t WS_W = 4 * MiB;
constexpr size_t WS_XT = 48 * MiB;
#define XB_PTR(a) ((bf16_t*)((a).ws + 112 * MiB))
#define MIX_PTR(a) ((bf16_t*)(a).out + (size_t)MTOK * DM)
constexpr size_t WS_BIG = 176 * MiB;
constexpr size_t WS_END = 416 * MiB;
constexpr size_t W_GU1 = 0, W_D1 = W_GU1 + (size_t)2 * DFF * DM, W_IN = W_D1 + (size_t)DM * DFF, W_OUT = W_IN + (size_t)DIN * DM,
                 W_GU2 = W_OUT + (size_t)DM * DM, W_D2 = W_GU2 + (size_t)2 * DFF * DM, W_TOT = W_D2 + (size_t)DM * DFF;
static_assert(WS_W + W_TOT * 2 <= 48 * MiB, "weights fit");

constexpr int LDS_BYTES = 147456;

struct Args { const float* in[21]; float* out; unsigned char* ws; int ph_lo, ph_hi; };

__device__ __forceinline__ unsigned cvt_pk_bf16(float lo, float hi) { unsigned r; asm volatile("v_cvt_pk_bf16_f32 %0, %1, %2" : "=v"(r) : "v"(lo), "v"(hi)); return r; }
__device__ __forceinline__ float bf2f(unsigned short b) { return __uint_as_float(((unsigned)b) << 16); }
__device__ __forceinline__ float bflo(unsigned w) { return __uint_as_float(w << 16); }
__device__ __forceinline__ float bfhi(unsigned w) { return __uint_as_float(w & 0xffff0000u); }
__device__ __forceinline__ float fast_rcp(float x) { return __builtin_amdgcn_rcpf(x); }
__device__ __forceinline__ float fast_exp(float x) { return __builtin_amdgcn_exp2f(x * LOG2E); }
__device__ __forceinline__ float sigmoidf_(float x) { return fast_rcp(1.0f + fast_exp(-x)); }
__device__ __forceinline__ float wave_sum(float v) {
#pragma unroll
    for (int o = 1; o < 64; o <<= 1) v += __shfl_xor(v, o);
    return v;
}
__device__ __forceinline__ float wave_max(float v) {
#pragma unroll
    for (int o = 1; o < 64; o <<= 1) v = fmaxf(v, __shfl_xor(v, o));
    return v;
}
#define LDS_WAIT() asm volatile("s_waitcnt lgkmcnt(0)" ::: "memory")

namespace pg8 {
constexpr int BM = 256, BK = 64, HALF = 128, HTB = HALF * BK * 2, STAGE_BYTES = 8 * HTB, NXCD = 8, WGM = 8;
__host__ __device__ __forceinline__ int lds_byte(int r, int c) { const int st = (r >> 4) * 2 + (c >> 5), rr = r & 15, cc = c & 31, ob = rr * 64 + cc * 2; return st * 1024 + (ob ^ (((ob >> 9) & 1) << 5)); }
__host__ __device__ __forceinline__ void stage_rc(int b, int& R, int& C) { const int st = b / 1024, sb = b % 1024, swz = sb ^ (((sb >> 9) & 1) << 5); R = (st >> 1) * 16 + swz / 64; C = (st & 1) * 32 + (swz % 64) / 2; }
__host__ __device__ __forceinline__ int perm32(int rho) { const int n = rho >> 4, i = rho & 15; return 8 * (i >> 2) + 4 * n + (i & 3); }

struct Unit { int pm, pn; };
struct Gemm { const bf16_t* A; const bf16_t* Bt; int M, N, K; };

template <int NN>
struct StaticOrderT {
    static constexpr int nM = MTOK / BM, nN = NN, nwg = nM * nN;
    int G, c;
    __device__ void init(int G_, int c_) { G = G_; c = c_; }
    __device__ __forceinline__ bool next(int i, Unit& u) const {
        const int L = i * G + c; if (L >= nwg) return false;
        int wgid = L; { constexpr int q = nwg / NXCD, r = nwg % NXCD; const int xcd = wgid % NXCD, off = wgid / NXCD; wgid = (xcd < r ? xcd * (q + 1) : r * (q + 1) + (xcd - r) * q) + off; }
        constexpr int nig = WGM * nN; const int gid = wgid / nig, fm = gid * WGM, gsz = (nM - fm) < WGM ? (nM - fm) : WGM;
        u.pm = fm + ((wgid % nig) % gsz); u.pn = (wgid % nig) / gsz; return true;
    }
};

__device__ __forceinline__ float row_rstd(const float* rowsq, int r) {
    const f32x4* p = (const f32x4*)(rowsq + (size_t)r * 16); const f32x4 a = p[0], b = p[1], c = p[2], d = p[3];
    const float s = (((a[0] + a[1]) + (a[2] + a[3])) + ((b[0] + b[1]) + (b[2] + b[3]))) + (((c[0] + c[1]) + (c[2] + c[3])) + ((d[0] + d[1]) + (d[2] + d[3])));
    return __builtin_amdgcn_rsqf(s * (1.0f / DM) + RMS_EPS);
}
constexpr int RSTD_LDS = 131072;
struct EpiSwiGLU {
    static constexpr bool NEEDS_RSTD = true;
    bf16_t* H; const float* rowsq;
    __device__ __forceinline__ void operator()(const f32x4 (&acc)[2][2][4][2], const Unit& u, int wr, int wc, int fr, int fq, const LAS float* rstd) const {
        const int row0 = u.pm * BM + wr * 64 + fr, col0 = u.pn * HALF + wc * 32 + 8 * fq;
#pragma unroll
        for (int ai = 0; ai < 2; ++ai)
#pragma unroll
            for (int m = 0; m < 4; ++m) {
                const int r = row0 + ai * HALF + m * 16;
                const float rs = rstd[ai * HALF + wr * 64 + m * 16 + fr];
                float hv[8];
#pragma unroll
                for (int n = 0; n < 2; ++n)
#pragma unroll
                    for (int j = 0; j < 4; ++j) { const float g = acc[ai][0][m][n][j] * rs, up = acc[ai][1][m][n][j] * rs; hv[4 * n + j] = g * up * fast_rcp(1.0f + fast_exp(-g)); }
                u32x4 w; w.x = cvt_pk_bf16(hv[0], hv[1]); w.y = cvt_pk_bf16(hv[2], hv[3]); w.z = cvt_pk_bf16(hv[4], hv[5]); w.w = cvt_pk_bf16(hv[6], hv[7]);
                *(u32x4*)(H + (size_t)r * DFF + col0) = w;
            }
    }
};
struct EpiProj {
    static constexpr bool NEEDS_RSTD = true;
    bf16_t* O; int ldc; const float* rowsq;
    __device__ __forceinline__ void operator()(const f32x4 (&acc)[2][2][4][2], const Unit& u, int wr, int wc, int fr, int fq, const LAS float* rstd) const {
        const int row0 = u.pm * BM + wr * 64 + fr, col0 = u.pn * BM + wc * 32 + 8 * fq;
#pragma unroll
        for (int ai = 0; ai < 2; ++ai)
#pragma unroll
            for (int m = 0; m < 4; ++m) {
                const int r = row0 + ai * HALF + m * 16;
                const float rs = rstd[ai * HALF + wr * 64 + m * 16 + fr];
#pragma unroll
                for (int bj = 0; bj < 2; ++bj) {
                    const f32x4 v0 = acc[ai][bj][m][0] * rs, v1 = acc[ai][bj][m][1] * rs;
                    u32x4 w; w.x = cvt_pk_bf16(v0[0], v0[1]); w.y = cvt_pk_bf16(v0[2], v0[3]); w.z = cvt_pk_bf16(v1[0], v1[1]); w.w = cvt_pk_bf16(v1[2], v1[3]);
                    *(u32x4*)(O + (size_t)r * ldc + col0 + bj * HALF) = w;
                }
            }
    }
};
__host__ __device__ __forceinline__ size_t xt_off(int pm, int pn, int wid, int ai, int m, int bj, int hf, int lane) {
    return ((((((((size_t)(pm * 4 + pn) * 8 + wid) * 2 + ai) * 4 + m) * 2 + bj) * 2 + hf) * 64) + lane) * 4;
}
constexpr int LOB = 4;
__host__ __device__ __forceinline__ size_t lo_off(int pm, int pn, int wid, int ai, int m, int bj, int lane) {
    return (((((((size_t)(pm * 4 + pn) * 8 + wid) * 2 + ai) * 4 + m) * 2 + bj) * 64) + lane) * LOB;
}
__device__ __forceinline__ unsigned res_enc(float y) { return (__float_as_uint(y) + (1u << (15 - LOB))) >> (16 - LOB); }
__device__ __forceinline__ unsigned res_hi(unsigned bL) { return (bL + (1u << (LOB - 1))) >> LOB; }
struct EpiResid {
    static constexpr bool NEEDS_RSTD = false;
    unsigned char* LO; bf16_t* XB; float* rowsq_out; float alpha; const float* rowsq; float* OUT;
    __device__ __forceinline__ void operator()(const f32x4 (&acc)[2][2][4][2], const Unit& u, int wr, int wc, int fr, int fq, const LAS float* rstd) const {
        const int row0 = u.pm * BM + wr * 64 + fr, col0 = u.pn * BM + wc * 32 + 8 * fq, lane = fq * 16 + fr;
#pragma unroll
        for (int ai = 0; ai < 2; ++ai)
#pragma unroll
            for (int m = 0; m < 4; ++m) {
                const int r = row0 + ai * HALF + m * 16;
                unsigned char* lp = LO + lo_off(u.pm, u.pn, wr * 4 + wc, ai, m, 0, lane);
                bf16_t* hp = XB + (size_t)r * DM + col0;
                float ss = 0.f;
#pragma unroll
                for (int bj = 0; bj < 2; ++bj) {
                    const u32x4 hw = *(const u32x4*)(hp + bj * HALF);
                    unsigned lw[2]; if (LOB == 8) { const u32x2 t = *(const u32x2*)(lp + bj * 64 * LOB); lw[0] = t.x; lw[1] = t.y; } else { lw[0] = *(const unsigned*)(lp + bj * 64 * LOB); lw[1] = 0u; }
                    float y[8];
#pragma unroll
                    for (int e = 0; e < 8; ++e) {
                        const unsigned hpart = (e & 1) ? (hw[e >> 1] & 0xffff0000u) : (hw[e >> 1] << 16);
                        const unsigned w = (LOB == 8) ? lw[e >> 2] : lw[0]; const int pos = (LOB == 8) ? 8 * (e & 3) : 4 * e;
                        const int lo = ((int)(w << (32 - LOB - pos))) >> (32 - LOB);
                        y[e] = __uint_as_float(hpart + (unsigned)(lo << (16 - LOB))) + acc[ai][bj][m][e >> 2][e & 3] * alpha;
                    }
                    if (OUT) { float* rowp = OUT + (size_t)r * DM + col0 + bj * HALF; *(f32x4*)rowp = (f32x4){y[0], y[1], y[2], y[3]}; *(f32x4*)(rowp + 4) = (f32x4){y[4], y[5], y[6], y[7]}; }
                    else {
                        u32x4 nh; unsigned nl0 = 0u, nl1 = 0u;
#pragma unroll
                        for (int i = 0; i < 4; ++i) {
                            const unsigned b0 = res_enc(y[2 * i]), b1 = res_enc(y[2 * i + 1]);
                            ss += y[2 * i] * y[2 * i] + y[2 * i + 1] * y[2 * i + 1];
                            nh[i] = (res_hi(b0) & 0xffffu) | (res_hi(b1) << 16);
                            const unsigned pr = (b0 & ((1u << LOB) - 1u)) | ((b1 & ((1u << LOB) - 1u)) << LOB);
                            if (LOB == 8) { if (i < 2) nl0 |= pr << (16 * i); else nl1 |= pr << (16 * (i - 2)); } else nl0 |= pr << (8 * i);
                        }
                        *(u32x4*)(hp + bj * HALF) = nh;
                        if (LOB == 8) { u32x2 nl; nl.x = nl0; nl.y = nl1; *(u32x2*)(lp + bj * 64 * LOB) = nl; } else *(unsigned*)(lp + bj * 64 * LOB) = nl0;
                    }
                }
                if (!OUT) { ss += __shfl_xor(ss, 16); ss += __shfl_xor(ss, 32);
                    if (fq == 0) rowsq_out[(size_t)r * 16 + u.pn * 4 + wc] = ss; }
                asm volatile("" ::: "memory");
            }
    }
};

template <class Epi, class Sched>
__device__ __forceinline__ void gemm_phase(LAS unsigned char* lds, const Gemm g, const Sched& S, const Epi& E, const int tid) {
    const int wid = __builtin_amdgcn_readfirstlane(tid >> 6), lane = tid & 63, wr = wid >> 2, wc = wid & 3, fr = lane & 15, fq = lane >> 4;
    const int K = g.K, nt = K / BK;
    unsigned voffA[2], voffB[2];
#pragma unroll
    for (int i = 0; i < 2; ++i) { int R, C; stage_rc(tid * 16 + i * 8192, R, C); const int Rb = (R & ~31) + perm32(R & 31);
        voffA[i] = (unsigned)(R * K + C) * 2u; voffB[i] = (unsigned)(Rb * K + C) * 2u; }
    const size_t kstep = (size_t)(BK * 2);
    const size_t hstep = (size_t)HALF * K * 2;
    const size_t tstep = 2 * hstep;
    const unsigned ldsw = (unsigned)wid * 1024u;
    const int aoff = lds_byte(wr * 64 + fr, fq * 8), boff = lds_byte(wc * 32 + fr, fq * 8);
#define PG8_SA(b, h) (((b) * 2 + (h)) * HTB)
#define PG8_SB(b, h) ((4 + (b) * 2 + (h)) * HTB)
#define PG8_STAGE(bufoff, gbase, voff) do { _Pragma("unroll") for (int _i = 0; _i < 2; ++_i) \
        __builtin_amdgcn_global_load_lds((const unsigned*)((const char*)(gbase) + (voff)[_i]), (LAS unsigned*)(lds + (bufoff) + ldsw + _i * 8192), 16, 0, 0); } while (0)
#define PG8_LDA(dst, b, h) do { _Pragma("unroll") for (int m = 0; m < 4; ++m) _Pragma("unroll") for (int k = 0; k < 2; ++k) dst[m][k] = *(const LAS bf16x8*)(lds + PG8_SA(b, h) + aoff + m * 2048 + k * 1024); } while (0)
#define PG8_LDB(dst, b, h) do { _Pragma("unroll") for (int n = 0; n < 2; ++n) _Pragma("unroll") for (int k = 0; k < 2; ++k) dst[n][k] = *(const LAS bf16x8*)(lds + PG8_SB(b, h) + boff + n * 2048 + k * 1024); } while (0)
#define PG8_MMA(ai, bj, At, Bt) do { __builtin_amdgcn_s_setprio(3); _Pragma("unroll") for (int m = 0; m < 4; ++m) _Pragma("unroll") for (int n = 0; n < 2; ++n) _Pragma("unroll") for (int k = 0; k < 2; ++k) \
        acc[ai][bj][m][n] = __builtin_amdgcn_mfma_f32_16x16x32_bf16(Bt[n][k], At[m][k], acc[ai][bj][m][n], 0, 0, 0); __builtin_amdgcn_s_setprio(0); } while (0)
#define PG8_WAIT_V(n) asm volatile("s_waitcnt vmcnt(" #n ")" ::: "memory")
#define PG8_WAIT_L(n) asm volatile("s_waitcnt lgkmcnt(" #n ")" ::: "memory")
#define PG8_BAR __builtin_amdgcn_s_barrier()
#define PG8_SCHED __builtin_amdgcn_sched_barrier(0)
    Unit cur, nxt; int ui = 0;
    if (!S.next(0, cur)) return;
    f32x4 acc[2][2][4][2];
#pragma unroll
    for (int a = 0; a < 2; ++a)
#pragma unroll
        for (int b = 0; b < 2; ++b)
#pragma unroll
            for (int m = 0; m < 4; ++m)
#pragma unroll
                for (int n = 0; n < 2; ++n) acc[a][b][m][n] = (f32x4){0.f, 0.f, 0.f, 0.f};
    bf16x8 At[4][2], B0[2][2], B1[2][2];
    const char* cA = (const char*)g.A + (size_t)cur.pm * tstep; const char* cB = (const char*)g.Bt + (size_t)cur.pn * tstep;
    PG8_STAGE(PG8_SB(0, 0), cB, voffB); PG8_STAGE(PG8_SB(0, 1), cB + hstep, voffB); PG8_STAGE(PG8_SA(0, 0), cA, voffA); PG8_STAGE(PG8_SA(0, 1), cA + hstep, voffA);
    if (wr == 1) PG8_BAR;
    PG8_WAIT_V(2); PG8_BAR;
    PG8_STAGE(PG8_SB(1, 0), cB + kstep, voffB); PG8_STAGE(PG8_SA(1, 0), cA + kstep, voffA); PG8_STAGE(PG8_SB(1, 1), cB + hstep + kstep, voffB);
    PG8_WAIT_V(6); PG8_BAR;
    for (;;) {
        const bool has_next = S.next(ui + 1, nxt);
        const char* nA = has_next ? (const char*)g.A + (size_t)nxt.pm * tstep : cA; const char* nB = has_next ? (const char*)g.Bt + (size_t)nxt.pn * tstep : cB;
        for (int t = 0; t < nt; t += 2) {
            const bool last = (t == nt - 2);
            const char* a1 = cA + (size_t)(t + 1) * kstep;
            const char* a2 = last ? nA : cA + (size_t)(t + 2) * kstep; const char* b2 = last ? nB : cB + (size_t)(t + 2) * kstep;
            const char* a3 = a2 + kstep; const char* b3 = b2 + kstep;
            PG8_LDB(B0, 0, 0); PG8_LDB(B1, 0, 1); PG8_SCHED; PG8_LDA(At, 0, 0); PG8_STAGE(PG8_SA(1, 1), a1 + hstep, voffA);
            PG8_WAIT_V(8); PG8_WAIT_L(0); PG8_BAR; PG8_MMA(0, 0, At, B0); PG8_MMA(0, 1, At, B1); PG8_BAR; PG8_SCHED;
            PG8_LDA(At, 0, 1); PG8_STAGE(PG8_SB(0, 0), b2, voffB); PG8_STAGE(PG8_SB(0, 1), b2 + hstep, voffB); PG8_STAGE(PG8_SA(0, 0), a2, voffA);
            PG8_WAIT_V(8); PG8_WAIT_L(0); PG8_BAR; PG8_MMA(1, 0, At, B0); PG8_MMA(1, 1, At, B1); PG8_BAR; PG8_SCHED;
            PG8_LDB(B0, 1, 0); PG8_LDB(B1, 1, 1); PG8_SCHED; PG8_LDA(At, 1, 0); PG8_STAGE(PG8_SA(0, 1), a2 + hstep, voffA);
            PG8_WAIT_V(8); PG8_WAIT_L(0); PG8_BAR; PG8_MMA(0, 0, At, B0); PG8_MMA(0, 1, At, B1); PG8_BAR; PG8_SCHED;
            PG8_LDA(At, 1, 1); PG8_STAGE(PG8_SB(1, 0), b3, voffB); PG8_STAGE(PG8_SB(1, 1), b3 + hstep, voffB); PG8_STAGE(PG8_SA(1, 0), a3, voffA);
            PG8_WAIT_V(8); PG8_WAIT_L(0); PG8_BAR; PG8_MMA(1, 0, At, B0); PG8_MMA(1, 1, At, B1); PG8_BAR; PG8_SCHED;
        }
        if (wr == 0) PG8_BAR;
        if constexpr (Epi::NEEDS_RSTD) {
            if (tid < 256) ((LAS float*)(lds + RSTD_LDS))[tid] = row_rstd(E.rowsq, cur.pm * BM + tid);
            PG8_WAIT_L(0); PG8_BAR;
        }
        E(acc, cur, wr, wc, fr, fq, (const LAS float*)(lds + RSTD_LDS));
        if (!has_next) break;
#pragma unroll
        for (int a = 0; a < 2; ++a)
#pragma unroll
            for (int b = 0; b < 2; ++b)
#pragma unroll
                for (int m = 0; m < 4; ++m)
#pragma unroll
                    for (int n = 0; n < 2; ++n) acc[a][b][m][n] = (f32x4){0.f, 0.f, 0.f, 0.f};
        cur = nxt; cA = nA; cB = nB; ++ui;
        if (wr == 1) PG8_BAR;
    }
    PG8_WAIT_V(0);
    PG8_BAR;
#undef PG8_SA
#undef PG8_SB
#undef PG8_STAGE
#undef PG8_LDA
#undef PG8_LDB
#undef PG8_MMA
#undef PG8_WAIT_V
#undef PG8_WAIT_L
#undef PG8_BAR
#undef PG8_SCHED
}
}

__device__ __forceinline__ void transpose_item(const float* __restrict__ W, int K, int N, bf16_t* __restrict__ WT, const float* __restrict__ gain, int mode, LAS float* scr, int item, int lane) {
    (void)scr;
    const int nblk = N / 32, kb = item / nblk, nb = item % nblk, c = lane & 7, ng = lane >> 3, k0 = 64 * kb + 8 * c, n0 = 32 * nb + 4 * ng;
    f32x4 v[8];
#pragma unroll
    for (int j = 0; j < 8; ++j) v[j] = *(const f32x4*)(W + (size_t)(k0 + j) * N + n0);
    if (gain) { const f32x4 g0 = *(const f32x4*)(gain + k0), g1 = *(const f32x4*)(gain + k0 + 4);
#pragma unroll
        for (int j = 0; j < 4; ++j) { v[j] = v[j] * g0[j]; v[4 + j] = v[4 + j] * g1[j]; } }
#pragma unroll
    for (int i = 0; i < 4; ++i) { const int nn = n0 + i; const int drow = (mode == 0) ? nn : (256 * (nn >> 7) + (nn & 127) + (mode == 2 ? 128 : 0));
        u32x4 o; o.x = cvt_pk_bf16(v[0][i], v[1][i]); o.y = cvt_pk_bf16(v[2][i], v[3][i]); o.z = cvt_pk_bf16(v[4][i], v[5][i]); o.w = cvt_pk_bf16(v[6][i], v[7][i]);
        *(u32x4*)(WT + (size_t)drow * K + k0) = o; }
}
constexpr int IT_GU = (DM / 64) * (DFF / 32), IT_DN = (DFF / 64) * (DM / 32), IT_IN = (DM / 64) * (DIN / 32), IT_OUT = (DM / 64) * (DM / 32);
__device__ __forceinline__ void convert_part(const Args& a, int l, int part, LAS unsigned char* lds, int gw, int ngw, int wave, int lane) {
    LAS float* scr = (LAS float*)(lds + wave * 8448);
    bf16_t* wb = (bf16_t*)(a.ws + WS_W);
    if (part == 0) {
        constexpr int NIT = 3 * IT_GU + IT_IN;
        for (int it = gw; it < NIT; it += ngw) {
            int r = it;
            if (r < IT_GU) { transpose_item(a.in[2] + (size_t)l * DM * DFF, DM, DFF, wb + W_GU1, a.in[1] + l * DM, 1, scr, r, lane); continue; } r -= IT_GU;
            if (r < IT_GU) { transpose_item(a.in[3] + (size_t)l * DM * DFF, DM, DFF, wb + W_GU1, a.in[1] + l * DM, 2, scr, r, lane); continue; } r -= IT_GU;
            if (r < IT_DN) { transpose_item(a.in[4] + (size_t)l * DFF * DM, DFF, DM, wb + W_D1, nullptr, 0, scr, r, lane); continue; } r -= IT_DN;
            transpose_item(a.in[6] + (size_t)l * DM * DIN, DM, DIN, wb + W_IN, a.in[5] + l * DM, 0, scr, r, lane);
        }
    } else {
        constexpr int NIT = 3 * IT_GU + IT_OUT;
        for (int it = gw; it < NIT; it += ngw) {
            int r = it;
            if (r < IT_OUT) { transpose_item(a.in[16] + (size_t)l * DM * DM, DM, DM, wb + W_OUT, nullptr, 0, scr, r, lane); continue; } r -= IT_OUT;
            if (r < IT_GU) { transpose_item(a.in[18] + (size_t)l * DM * DFF, DM, DFF, wb + W_GU2, a.in[17] + l * DM, 1, scr, r, lane); continue; } r -= IT_GU;
            if (r < IT_GU) { transpose_item(a.in[19] + (size_t)l * DM * DFF, DM, DFF, wb + W_GU2, a.in[17] + l * DM, 2, scr, r, lane); continue; } r -= IT_GU;
            transpose_item(a.in[20] + (size_t)l * DFF * DM, DFF, DM, wb + W_D2, nullptr, 0, scr, r, lane);
        }
    }
}

__device__ __forceinline__ void p0_rows(const Args& a, int gw, int ngw, int lane) {
    const float* x = a.in[0]; bf16_t* xb = XB_PTR(a); float* rowsq = (float*)(a.ws + WS_ROWSQ); unsigned char* xlo = (unsigned char*)(a.ws + WS_XT);
    for (int m = gw; m < MTOK; m += ngw) {
        const f32x4* xr = (const f32x4*)(x + (size_t)m * DM) + lane;
        u32x2* brow = (u32x2*)(xb + (size_t)m * DM) + lane;
        const int pm = m >> 8, rr = m & 255, ai = rr >> 7, wr = (rr >> 6) & 1, mm = (rr >> 4) & 3, fr = rr & 15;
        float s = 0.f;
#pragma unroll
        for (int j = 0; j < 4; ++j) { const f32x4 v = xr[64 * j]; s += (v[0] * v[0] + v[1] * v[1]) + (v[2] * v[2] + v[3] * v[3]);
            const int c = 4 * lane + 256 * j, pn = c >> 8, cc = c & 255, bj = cc >> 7, wc = (cc >> 5) & 3, fq = (cc >> 3) & 3, hf = (cc >> 2) & 1;
            const unsigned b0 = pg8::res_enc(v[0]), b1 = pg8::res_enc(v[1]), b2 = pg8::res_enc(v[2]), b3 = pg8::res_enc(v[3]);
            u32x2 h; h.x = (pg8::res_hi(b0) & 0xffffu) | (pg8::res_hi(b1) << 16); h.y = (pg8::res_hi(b2) & 0xffffu) | (pg8::res_hi(b3) << 16);
            brow[64 * j] = h;
            unsigned char* lpp = xlo + pg8::lo_off(pm, pn, wr * 4 + wc, ai, mm, bj, fq * 16 + fr) + (pg8::LOB / 2) * hf;
            if (pg8::LOB == 8) *(unsigned*)lpp = (b0 & 0xffu) | ((b1 & 0xffu) << 8) | ((b2 & 0xffu) << 16) | (b3 << 24);
            else *(unsigned short*)lpp = (unsigned short)((b0 & 0xfu) | ((b1 & 0xfu) << 4) | ((b2 & 0xfu) << 8) | ((b3 & 0xfu) << 12)); }
        s = wave_sum(s);
        if (lane < 16) rowsq[(size_t)m * 16 + lane] = lane == 0 ? s : 0.f;
    }
}

constexpr int LRU_NITEMS = NBATCH * 12 * 32;
template <bool FINAL>
__device__ __forceinline__ void lru_phase(LAS unsigned char* lds, const Args& a, int l, int blk, int G, int wave, int lane) {
    const bf16_t* proj = (const bf16_t*)(a.ws + WS_BIG); bf16_t* mix = MIX_PTR(a); float* summ = (float*)(a.ws + WS_SUMM);
    LAS unsigned char* wl = lds + wave * 11264;
    LAS bf16_t* XC = (LAS bf16_t*)wl;
    LAS float* PRE = (LAS float*)(wl + 2304);
    LAS float* SEG = (LAS float*)(lds + 8 * 11264);
    LAS float* CARRY = SEG + 1024;
    const int fr = lane & 15, fq = lane >> 4;
    const int per = (LRU_NITEMS + G - 1) / G, it0 = blk * per, it1 = (it0 + per < LRU_NITEMS) ? it0 + per : LRU_NITEMS;
    int cur_seq = -1;
    bf16x8 Bf[2][4][2]; float cw0 = 0, cw1 = 0, cw2 = 0, cw3 = 0, cb = 0, ba = 0, bx = 0, sp = 0, ba2 = 0, bx2 = 0, c2 = 0;
    unsigned short xr[19], gr[16];
#define LRU_LOAD(itn) do { const int seq_ = (itn) >> 5, chunk_ = (itn) & 31, b_ = seq_ / 12, hb_ = seq_ - b_ * 12, t0_ = chunk_ * 128 + 16 * wave; \
        const bf16_t* xp_ = proj + (size_t)b_ * SEQ * DIN + LXOFF + hb_ * 64 + lane; \
        _Pragma("unroll") for (int i = 0; i < 19; ++i) { const int t = t0_ - 3 + i; xr[i] = xp_[(size_t)(t < 0 ? 0 : t) * DIN]; } \
        if (FINAL) { const bf16_t* gp_ = xp_ + (LGOFF - LXOFF); _Pragma("unroll") for (int i = 0; i < 16; ++i) gr[i] = gp_[(size_t)(t0_ + i) * DIN]; } } while (0)
    if (it0 < it1) LRU_LOAD(it0);
    for (int it = it0; it < it1; ++it) {
        const int seq = it >> 5, chunk = it & 31, b = seq / 12, hb = seq - b * 12;
        if (seq != cur_seq) {
            cur_seq = seq;
            const int ch = hb * 64 + lane;
            cw0 = a.in[9][(l * 4 + 0) * DLRU + ch]; cw1 = a.in[9][(l * 4 + 1) * DLRU + ch]; cw2 = a.in[9][(l * 4 + 2) * DLRU + ch]; cw3 = a.in[9][(l * 4 + 3) * DLRU + ch];
            cb = a.in[10][l * DLRU + ch]; ba = a.in[12][l * DLRU + ch]; bx = a.in[14][l * DLRU + ch];
            sp = log1pf(expf(-a.in[15][l * DLRU + ch]));
            ba2 = -ba * LOG2E; bx2 = -bx * LOG2E; c2 = -8.0f * sp * LOG2E;
#pragma unroll
            for (int gg = 0; gg < 2; ++gg) { const float* Wg = a.in[gg ? 13 : 11] + ((size_t)(l * 12 + hb)) * 4096;
#pragma unroll
                for (int nt = 0; nt < 4; ++nt)
#pragma unroll
                    for (int ks = 0; ks < 2; ++ks) { float wv[8];
#pragma unroll
                        for (int jj = 0; jj < 8; ++jj) wv[jj] = Wg[(32 * ks + 8 * fq + jj) * 64 + 16 * nt + fr];
                        u32x4 w; w.x = cvt_pk_bf16(wv[0], wv[1]); w.y = cvt_pk_bf16(wv[2], wv[3]); w.z = cvt_pk_bf16(wv[4], wv[5]); w.w = cvt_pk_bf16(wv[6], wv[7]);
                        Bf[gg][nt][ks] = __builtin_bit_cast(bf16x8, w); } }
            if (FINAL) {
                __syncthreads();
                { const float* sp_ = summ + (size_t)seq * 32 * 128 + lane; float av[4], bv[4];
#pragma unroll
                  for (int k = 0; k < 4; ++k) { const int cc = 4 * wave + k; const float A = sp_[cc * 128], B = sp_[cc * 128 + 64]; av[k] = cc < chunk ? A : 1.f; bv[k] = cc < chunk ? B : 0.f; }
                  float A = 1.f, B = 0.f;
#pragma unroll
                  for (int k = 0; k < 4; ++k) { B = av[k] * B + bv[k]; A *= av[k]; }
                  SEG[(wave * 2 + 0) * 64 + lane] = A; SEG[(wave * 2 + 1) * 64 + lane] = B; }
                __syncthreads();
                if (wave == 0) { float h = 0.f;
#pragma unroll
                    for (int s2 = 0; s2 < 8; ++s2) h = SEG[(s2 * 2) * 64 + lane] * h + SEG[(s2 * 2 + 1) * 64 + lane];
                    CARRY[lane] = h; }
                __syncthreads();
            }
        }
        const int t0 = chunk * 128 + 16 * wave;
        float xv[19];
#pragma unroll
        for (int i = 0; i < 19; ++i) xv[i] = (t0 - 3 + i) < 0 ? 0.f : bf2f(xr[i]);
        float gv[16];
        if (FINAL) {
#pragma unroll
            for (int i = 0; i < 16; ++i) gv[i] = bf2f(gr[i]);
        }
        if (it + 1 < it1) LRU_LOAD(it + 1);
        float xc[16];
#pragma unroll
        for (int i = 0; i < 16; ++i) { xc[i] = cb + cw0 * xv[i] + cw1 * xv[i + 1] + cw2 * xv[i + 2] + cw3 * xv[i + 3]; XC[i * 72 + lane] = (bf16_t)(cvt_pk_bf16(xc[i], 0.f) & 0xffffu); }
        LDS_WAIT();
        bf16x8 af[2];
#pragma unroll
        for (int ks = 0; ks < 2; ++ks) af[ks] = *(const LAS bf16x8*)((const LAS unsigned char*)XC + fr * 144 + fq * 16 + ks * 64);
#pragma unroll
        for (int gg = 0; gg < 2; ++gg)
#pragma unroll
            for (int nt = 0; nt < 4; ++nt) { f32x4 c = (f32x4){0.f, 0.f, 0.f, 0.f};
#pragma unroll
                for (int ks = 0; ks < 2; ++ks) c = __builtin_amdgcn_mfma_f32_16x16x32_bf16(af[ks], Bf[gg][nt][ks], c, 0, 0, 0);
#pragma unroll
                for (int rg = 0; rg < 4; ++rg) PRE[gg * 16 * 68 + (4 * fq + rg) * 68 + 16 * nt + fr] = c[rg]; }
        LDS_WAIT();
        float h = 0.f, P = 1.f; float hl[16], Pl[16];
#pragma unroll
        for (int i = 0; i < 16; ++i) {
            const float r = fast_rcp(1.0f + __builtin_amdgcn_exp2f(__builtin_fmaf(PRE[i * 68 + lane], -LOG2E, ba2)));
            const float ig = fast_rcp(1.0f + __builtin_amdgcn_exp2f(__builtin_fmaf(PRE[16 * 68 + i * 68 + lane], -LOG2E, bx2)));
            const float aa = __builtin_amdgcn_exp2f(r * c2);
            const float bb = __builtin_sqrtf(fmaxf(1.0f - aa * aa, 0.f)) * ig * xc[i];
            h = aa * h + bb; P *= aa; hl[i] = h; Pl[i] = P;
        }
        SEG[(wave * 2 + 0) * 64 + lane] = P; SEG[(wave * 2 + 1) * 64 + lane] = h;
        __syncthreads();
        if (FINAL) {
            float hin = CARRY[lane];
            for (int s = 0; s < wave; ++s) hin = SEG[(s * 2) * 64 + lane] * hin + SEG[(s * 2 + 1) * 64 + lane];
            bf16_t* yp = mix + ((size_t)b * SEQ + t0) * DM + 256 + hb * 64 + lane;
#pragma unroll
            for (int i = 0; i < 16; ++i) { const float hv = hl[i] + Pl[i] * hin; const float g = gv[i];
                const float w2 = g * __builtin_fmaf(g * g, -1.5957691216f * 0.044715f * LOG2E, -1.5957691216f * LOG2E);
                const float y = hv * g * fast_rcp(1.0f + __builtin_amdgcn_exp2f(w2));
                yp[(size_t)i * DM] = (bf16_t)(cvt_pk_bf16(y, 0.f) & 0xffffu); }
            const float hout = P * hin + h;
            __syncthreads();
            if (wave == 7) CARRY[lane] = hout;
        } else {
            if (wave == 0) { float A = 1.f, B = 0.f;
#pragma unroll
                for (int s = 0; s < 8; ++s) { const float As = SEG[(s * 2) * 64 + lane], Bs = SEG[(s * 2 + 1) * 64 + lane]; B = As * B + Bs; A *= As; }
                float* sp_ = summ + ((size_t)seq * 32 + chunk) * 128 + lane; sp_[0] = A; sp_[64] = B; }
            __syncthreads();
        }
    }
#undef LRU_LOAD
    __syncthreads();
}

__device__ __forceinline__ float sumsq8(bf16x8 v) { const u32x4 w = __builtin_bit_cast(u32x4, v); float s = 0.f;
#pragma unroll
    for (int i = 0; i < 4; ++i) { const float lo = bflo(w[i]), hi = bfhi(w[i]); s += lo * lo + hi * hi; } return s; }
__device__ __forceinline__ s16x4 vtr(const LAS unsigned char* p) { typedef short v4i16_t __attribute__((ext_vector_type(4))); return __builtin_amdgcn_ds_read_tr16_b64_v4i16((LAS v4i16_t*)p); }

struct AttJob { const bf16_t* base; int rsh, rho, i0, koff, voff, qoff; };
constexpr int ATT_NITEMS = NBATCH * 4 * (SEQ / 256);
__device__ __forceinline__ AttJob att_make_job(const bf16_t* proj, int it, int jidx, int wave) {
    const int tile = it & 15, hs = (it >> 4) & 3, b = it >> 6, g = jidx >> 1, jb = jidx & 1;
    AttJob J; J.rsh = 2 * g; const int r = 1 << J.rsh, j = 2 * wave + jb; J.rho = j & (r - 1); const int sub = j >> J.rsh;
    J.i0 = ((tile * 256) >> J.rsh) + 16 * sub; J.base = proj + (size_t)b * SEQ * DIN;
    J.qoff = QOFF + g * 256 + hs * 64; J.koff = KOFF + g * 256 + hs * 64; J.voff = VOFF + g * 256 + hs * 64; return J;
}
__device__ __forceinline__ void attn_phase(LAS unsigned char* lds, const Args& a, int l, int vcu, int G, int wave, int lane) {
    const bf16_t* proj = (const bf16_t*)(a.ws + WS_BIG); bf16_t* mix = MIX_PTR(a);
    LAS float* O = (LAS float*)lds;
    LAS float* Z = (LAS float*)(lds + 256 * 68 * 4);
    LAS unsigned char* Vst = lds + 256 * 68 * 4 + 1024 + wave * 4608;
    const int fr = lane & 15, fq = lane >> 4, tid = wave * 64 + lane;
    const float* gq = a.in[7] + l * 64; const float* gk = a.in[8] + l * 64;
    const float mshift = 8.0f * wave_max(fabsf(gq[lane])) * wave_max(fabsf(gk[lane])) * LOG2E;
    LAS float* GQK = (LAS float*)(lds + 256 * 68 * 4 + 1024 + 8 * 4608);
    if (wave == 0) GQK[lane] = gq[lane] * gk[lane] * (0.125f * LOG2E);
    __syncthreads();
    if (vcu >= ATT_NITEMS) return;
    bf16x8 kf[5][2][2], vv[5][4], qn[2];
#define ATT_ISSUE_K(buf, J, p) do { \
        _Pragma("unroll") for (int aa = ((p) == 0 ? 1 : 0); aa < 2; ++aa) { const int ik = (J).i0 - 144 + 32 * (p) + 16 * aa + fr; const int ikc = ik < 0 ? 0 : ik; \
            const bf16_t* kp = (J).base + (size_t)((J).rho + (ikc << (J).rsh)) * DIN + (J).koff + 8 * fq; \
            kf[buf][aa][0] = *(const bf16x8*)kp; kf[buf][aa][1] = *(const bf16x8*)(kp + 32); } } while (0)
#define ATT_ISSUE_V(buf, J, p) do { \
        _Pragma("unroll") for (int i = 0; i < 4; ++i) { const int idx = lane + 64 * i, kk = idx >> 3, ch = idx & 7; const int ik = (J).i0 - 144 + 32 * (p) + kk; const int ikc = ik < 0 ? 0 : ik; \
            vv[buf][i] = *(const bf16x8*)((J).base + (size_t)((J).rho + (ikc << (J).rsh)) * DIN + (J).voff + 8 * ch); } } while (0)
#define ATT_ISSUE_Q(J) do { const bf16_t* qp = (J).base + (size_t)((J).rho + (((J).i0 + fr) << (J).rsh)) * DIN + (J).qoff + 8 * fq; qn[0] = *(const bf16x8*)qp; qn[1] = *(const bf16x8*)(qp + 32); } while (0)
    AttJob Jc = att_make_job(proj, vcu, 0, wave);
    ATT_ISSUE_Q(Jc); ATT_ISSUE_K(0, Jc, 0); ATT_ISSUE_V(0, Jc, 0); ATT_ISSUE_K(1, Jc, 1); ATT_ISSUE_K(2, Jc, 2);
    for (int it = vcu; it < ATT_NITEMS; it += G) {
        const int tile = it & 15, hs = (it >> 4) & 3, b = it >> 6, t0 = tile * 256;
        for (int jidx = 0; jidx < 6; ++jidx) {
            const int g = jidx >> 1;
            const bool has_next = (jidx < 5) || (it + G < ATT_NITEMS);
            const AttJob Jn = att_make_job(proj, (jidx < 5 || !has_next) ? it : it + G, jidx < 5 ? jidx + 1 : (has_next ? 0 : 5), wave);
            const float slope2 = exp2f(-8.0f * (float)(4 * g + hs + 1) / 12.0f) * (float)(1 << Jc.rsh) * LOG2E;
            bf16x8 qf[2];
            {
                const bf16x8 q0 = qn[0], q1 = qn[1];
                float ss = sumsq8(q0) + sumsq8(q1); ss += __shfl_xor(ss, 16); ss += __shfl_xor(ss, 32);
                const float rq = __builtin_amdgcn_rsqf(ss * (1.0f / 64.0f) + RMS_EPS);
                const u32x4 w0 = __builtin_bit_cast(u32x4, q0), w1 = __builtin_bit_cast(u32x4, q1); u32x4 o0, o1;
                const LAS f32x4* gp = (const LAS f32x4*)(GQK + 8 * fq);
                const f32x4 ga = gp[0] * rq, gb = gp[1] * rq, gc = gp[8] * rq, gd = gp[9] * rq;
                o0[0] = cvt_pk_bf16(bflo(w0[0]) * ga[0], bfhi(w0[0]) * ga[1]); o0[1] = cvt_pk_bf16(bflo(w0[1]) * ga[2], bfhi(w0[1]) * ga[3]);
                o0[2] = cvt_pk_bf16(bflo(w0[2]) * gb[0], bfhi(w0[2]) * gb[1]); o0[3] = cvt_pk_bf16(bflo(w0[3]) * gb[2], bfhi(w0[3]) * gb[3]);
                o1[0] = cvt_pk_bf16(bflo(w1[0]) * gc[0], bfhi(w1[0]) * gc[1]); o1[1] = cvt_pk_bf16(bflo(w1[1]) * gc[2], bfhi(w1[1]) * gc[3]);
                o1[2] = cvt_pk_bf16(bflo(w1[2]) * gd[0], bfhi(w1[2]) * gd[1]); o1[3] = cvt_pk_bf16(bflo(w1[3]) * gd[2], bfhi(w1[3]) * gd[3]);
                qf[0] = __builtin_bit_cast(bf16x8, o0); qf[1] = __builtin_bit_cast(bf16x8, o1);
            }
            f32x4 oacc[4];
#pragma unroll
            for (int dt = 0; dt < 4; ++dt) oacc[dt] = (f32x4){0.f, 0.f, 0.f, 0.f};
            float zsum = 0.f;
            const float laneb = -slope2 * (float)(fr - 4 * fq) - mshift;
#pragma unroll
            for (int p = 0; p < 5; ++p) {
                if (p + 3 < 5) { ATT_ISSUE_K(p + 3, Jc, p + 3); } else { ATT_ISSUE_K((p + 3) % 5, Jn, p + 3 - 5); }
                if (p + 1 < 5) { ATT_ISSUE_V(p + 1, Jc, p + 1); } else { ATT_ISSUE_V(0, Jn, 0); }
                if (p == 4) ATT_ISSUE_Q(Jn);
                const int ikb = Jc.i0 - 144 + 32 * p;
                float pv[2][4];
#pragma unroll
                for (int aa = 0; aa < 2; ++aa) {
                    if (p == 0 && aa == 0) { pv[0][0] = 0.f; pv[0][1] = 0.f; pv[0][2] = 0.f; pv[0][3] = 0.f; continue; }
                    const bf16x8 k0 = kf[p][aa][0], k1 = kf[p][aa][1];
                    f32x4 sc = (f32x4){0.f, 0.f, 0.f, 0.f};
                    sc = __builtin_amdgcn_mfma_f32_16x16x32_bf16(k0, qf[0], sc, 0, 0, 0);
                    sc = __builtin_amdgcn_mfma_f32_16x16x32_bf16(k1, qf[1], sc, 0, 0, 0);
                    f32x4 kk2 = (f32x4){0.f, 0.f, 0.f, 0.f};
                    kk2 = __builtin_amdgcn_mfma_f32_16x16x32_bf16(k0, k0, kk2, 0, 0, 0);
                    kk2 = __builtin_amdgcn_mfma_f32_16x16x32_bf16(k1, k1, kk2, 0, 0, 0);
                    const int base = 144 - 32 * p - 16 * aa;
                    const bool chk_hi = (p == 0 && aa == 1), chk_lo = (p == 4 && aa == 1);
#pragma unroll
                    for (int rg = 0; rg < 4; ++rg) {
                        const float rkk = __builtin_amdgcn_rsqf(__shfl(kk2[rg], 20 * fq + rg) * (1.0f / 64.0f) + RMS_EPS);
                        const int ik = ikb + 16 * aa + 4 * fq + rg;
                        bool valid = (ik >= 0);
                        if (chk_hi) valid = valid && (fr - 4 * fq - rg + base <= 128);
                        if (chk_lo) valid = valid && (fr - 4 * fq - rg + base >= 0);
                        const float e = __builtin_fmaf(sc[rg], rkk, __builtin_fmaf(-slope2, (float)(base - rg), laneb));
                        const float pe = valid ? __builtin_amdgcn_exp2f(e) : 0.f;
                        pv[aa][rg] = pe; zsum += pe;
                    }
                }
                u32x4 pw; pw.x = cvt_pk_bf16(pv[0][0], pv[0][1]); pw.y = cvt_pk_bf16(pv[0][2], pv[0][3]); pw.z = cvt_pk_bf16(pv[1][0], pv[1][1]); pw.w = cvt_pk_bf16(pv[1][2], pv[1][3]);
                const bf16x8 pb = __builtin_bit_cast(bf16x8, pw);
#pragma unroll
                for (int i = 0; i < 4; ++i) { const int idx = lane + 64 * i, kk = idx >> 3, ch = idx & 7; *(LAS bf16x8*)(Vst + kk * 144 + ch * 16) = vv[p][i]; }
                LDS_WAIT();
                const LAS unsigned char* vb = Vst + (4 * fq + (fr >> 2)) * 144 + (fr & 3) * 8;
#pragma unroll
                for (int dt = 0; dt < 4; ++dt) {
                    const s16x4 lo = vtr(vb + dt * 32), hi = vtr(vb + 16 * 144 + dt * 32);
                    const bf16x8 va = (bf16x8){lo[0], lo[1], lo[2], lo[3], hi[0], hi[1], hi[2], hi[3]};
                    oacc[dt] = __builtin_amdgcn_mfma_f32_16x16x32_bf16(va, pb, oacc[dt], 0, 0, 0);
                }
                LDS_WAIT();
                asm volatile("" ::: "memory");
            }
            zsum += __shfl_xor(zsum, 16); zsum += __shfl_xor(zsum, 32);
            const int tl = Jc.rho + (((Jc.i0 - (t0 >> Jc.rsh)) + fr) << Jc.rsh);
            LAS f32x4* op = (LAS f32x4*)(O + tl * 68 + 4 * fq);
            if (g == 0) {
#pragma unroll
                for (int dt = 0; dt < 4; ++dt) op[4 * dt] = oacc[dt];
                if (fq == 0) Z[tl] = zsum;
            } else {
#pragma unroll
                for (int dt = 0; dt < 4; ++dt) { const f32x4 o = op[4 * dt]; op[4 * dt] = o + oacc[dt]; }
                if (fq == 0) Z[tl] += zsum;
            }
            Jc = Jn;
            if (jidx & 1) __syncthreads();
        }
        {
            const int tok = tid >> 1, half = tid & 1;
            const float inv = 1.0f / Z[tok];
            const LAS f32x4* op = (const LAS f32x4*)(O + tok * 68 + 32 * half);
            bf16_t* dst = mix + ((size_t)b * SEQ + t0 + tok) * DM + hs * 64 + 32 * half;
#pragma unroll
            for (int i = 0; i < 4; ++i) { const f32x4 v0 = op[2 * i] * inv, v1 = op[2 * i + 1] * inv;
                u32x4 w; w.x = cvt_pk_bf16(v0[0], v0[1]); w.y = cvt_pk_bf16(v0[2], v0[3]); w.z = cvt_pk_bf16(v1[0], v1[1]); w.w = cvt_pk_bf16(v1[2], v1[3]);
                *(u32x4*)(dst + 8 * i) = w; }
        }
        __syncthreads();
    }
#undef ATT_ISSUE_K
#undef ATT_ISSUE_V
#undef ATT_ISSUE_Q
}


constexpr size_t WS_CTL = 3 * MiB + 512 * 1024;
constexpr int CTL_BYTES = 16384;
constexpr int LDS_MISC = 140000;
#define XB_TMO      128
#define XB_XCNT(j)  (256  + 64 * (j))
#define XB_XSUB(j)  (1280 + 64 * (j))
#define XB_XGEN(j)  (2304 + 64 * (j))
#define XB_TOP      3328
#define XB_TOPGEN   3392
#define XB_SPIN_CAP (1u << 18)
__device__ __forceinline__ unsigned xb_ld(unsigned* p)              { return __hip_atomic_load(p, __ATOMIC_RELAXED, __HIP_MEMORY_SCOPE_AGENT); }
__device__ __forceinline__ unsigned xb_add(unsigned* p, unsigned v) { return __hip_atomic_fetch_add(p, v, __ATOMIC_RELAXED, __HIP_MEMORY_SCOPE_AGENT); }
__device__ __forceinline__ unsigned xb_xcc_id() { return (unsigned)__builtin_amdgcn_s_getreg((3 << 11) | 20) & 0xFu; }
#define XB_SPIN(cond, bar) do { unsigned _sp = 0; while (cond) { __builtin_amdgcn_s_sleep(1); \
    if ((++_sp & 255u) == 0u) { if (xb_ld(&(bar)[XB_TMO])) break; if (_sp > XB_SPIN_CAP) { atomicAdd(&(bar)[XB_TMO], 1u); break; } } } } while (0)
__device__ __forceinline__ void xcd_barrier_complete(unsigned* bar, unsigned x, unsigned& nloc, unsigned& nx) {
    const unsigned G = gridDim.x * gridDim.y * gridDim.z;
    unsigned sum, cnt, mine, sp = 0u;
    for (;;) {
        sum = 0u; cnt = 0u; mine = 0u;
#pragma unroll
        for (unsigned j = 0; j < 16; ++j) { const unsigned c = xb_ld(&bar[XB_XCNT(j)]); sum += c; cnt += (c > 0u) ? 1u : 0u; mine = (j == x) ? c : mine; }
        if (sum == G) break;
        __builtin_amdgcn_s_sleep(1);
        if ((++sp & 255u) == 0u) { if (xb_ld(&bar[XB_TMO])) break; if (sp > XB_SPIN_CAP) { atomicAdd(&bar[XB_TMO], 1u); break; } }
    }
    nloc = mine > 0u ? mine : 1u; nx = cnt > 0u ? cnt : 1u;
}
__device__ __forceinline__ void xcd_barrier(unsigned* bar, volatile LAS unsigned* st) {
    asm volatile("s_waitcnt vmcnt(0)" ::: "memory");
    __syncthreads();
    if (threadIdx.x == 0) {
        __builtin_amdgcn_s_waitcnt(0);
        const unsigned x = xb_xcc_id();
        unsigned nloc = st[0], nx = st[1];
        if (nloc == 0u) { xcd_barrier_complete(bar, x, nloc, nx); st[0] = nloc; st[1] = nx; }
        const unsigned old = xb_add(&bar[XB_XSUB(x)], 1u);
        const unsigned gen = old / nloc;
        if (old + 1u == (gen + 1u) * nloc) {
            __builtin_amdgcn_fence(__ATOMIC_RELEASE, "agent");
            asm volatile("s_waitcnt vmcnt(0)" ::: "memory");
            const unsigned og = xb_add(&bar[XB_TOP], 1u);
            const unsigned tg = og / nx;
            if (og + 1u == (tg + 1u) * nx) xb_add(&bar[XB_TOPGEN], 1u);
            else XB_SPIN(xb_ld(&bar[XB_TOPGEN]) == tg, bar);
            __builtin_amdgcn_fence(__ATOMIC_ACQUIRE, "agent");
            xb_add(&bar[XB_XGEN(x)], 1u);
            asm volatile("s_waitcnt vmcnt(0)" ::: "memory");
        } else {
            XB_SPIN(xb_ld(&bar[XB_XGEN(x)]) == gen, bar);
            __builtin_amdgcn_fence(__ATOMIC_ACQUIRE, "agent");
            asm volatile("s_waitcnt vmcnt(0)" ::: "memory");
        }
    }
    __syncthreads();
}

__global__ void __launch_bounds__(512, 2) trunk_fwd(Args a) {
    extern __shared__ __attribute__((aligned(16))) unsigned char lds_raw[];
    LAS unsigned char* lds = (LAS unsigned char*)lds_raw;
    cg::grid_group grid = cg::this_grid();
    unsigned* barw = (unsigned*)(a.ws + WS_CTL);
    volatile LAS unsigned* bst = (volatile LAS unsigned*)(lds + LDS_MISC);
    if (threadIdx.x == 0) { bst[0] = 0u; bst[1] = 0u; if (a.ph_hi - a.ph_lo > 1) (void)xb_add(&barw[XB_XCNT(xb_xcc_id())], 1u); }
    __syncthreads();
    bool redo = false; int nseam = 0;
    for (int ph = a.ph_lo; ph < a.ph_hi; ++ph) {
        if (a.ph_lo < 0) grid.sync();
        if (nseam >= 1) xcd_barrier(barw, bst);
        ++nseam;

        int tid = threadIdx.x; asm volatile("" : "+v"(tid));
        int G = gridDim.x, blk = blockIdx.x; asm volatile("" : "+s"(G), "+s"(blk));
        unsigned char* wsb = a.ws; asm volatile("" : "+s"(wsb));
        const int lane = tid & 63, wave = __builtin_amdgcn_readfirstlane(tid >> 6);
        const int gw = blk * 8 + wave, ngw = G * 8;
        bf16_t* wb = (bf16_t*)(wsb + WS_W); bf16_t* xb = XB_PTR(a); bf16_t* mixb = MIX_PTR(a); bf16_t* big = (bf16_t*)(wsb + WS_BIG);
        float* rowsq = (float*)(wsb + WS_ROWSQ);
        if (ph == 0) { p0_rows(a, gw, ngw, lane); convert_part(a, 0, 0, lds, gw, ngw, wave, lane); continue; }
        const int l = (ph - 1) >> 3, s = (ph - 1) & 7;
        if (s == 0 || s == 6) {
            pg8::Gemm g{xb, wb + (s == 0 ? W_GU1 : W_GU2), MTOK, 2 * DFF, DM}; pg8::StaticOrderT<2 * DFF / 256> S; S.init(G, blk);
            pg8::EpiSwiGLU E{big, rowsq};
            pg8::gemm_phase<pg8::EpiSwiGLU, pg8::StaticOrderT<2 * DFF / 256>>(lds, g, S, E, tid);
        } else if (s == 1 || s == 7 || s == 5) {
            const bool isout = (s == 5);
            pg8::Gemm g{isout ? mixb : big, wb + (s == 1 ? W_D1 : (s == 7 ? W_D2 : W_OUT)), MTOK, DM, isout ? DM : DFF}; pg8::StaticOrderT<DM / 256> S; S.init(G, blk);
            pg8::EpiResid E{(unsigned char*)(wsb + WS_XT), xb, rowsq, isout ? 1.0f : 0.5f, nullptr, (ph == NPH - 1) ? a.out : nullptr};
            pg8::gemm_phase<pg8::EpiResid, pg8::StaticOrderT<DM / 256>>(lds, g, S, E, tid);
        } else if (s == 2) {
            pg8::Gemm g{xb, wb + W_IN, MTOK, DIN, DM}; pg8::StaticOrderT<DIN / 256> S; S.init(G, blk);
            pg8::EpiProj E{big, DIN, rowsq};
            pg8::gemm_phase<pg8::EpiProj, pg8::StaticOrderT<DIN / 256>>(lds, g, S, E, tid);
            { const int nun = (MTOK / 256) * (DIN / 256), nx = nun - (nun / G) * G;
              if (nx > 0 && blk >= nx) convert_part(a, l, 1, lds, (blk - nx) * 8 + wave, (G - nx) * 8, wave, lane); }
        } else if (s == 3) {
            for (int rep = 0; rep <= DUP_CONV; ++rep) {
            { const int nun = (MTOK / 256) * (DIN / 256); if (nun % G == 0) convert_part(a, l, 1, lds, gw, ngw, wave, lane); }
            if (l + 1 < DEPTH) convert_part(a, l + 1, 0, lds, gw, ngw, wave, lane);
            __syncthreads(); }
            for (int rep = 0; rep <= DUP_LRU1; ++rep) lru_phase<false>(lds, a, l, blk, G, wave, lane);
            for (int rep = 0; rep <= DUP_ATT; ++rep)
            { const int vcu = (G % 8 == 0) ? (blk % 8) * (G / 8) + blk / 8 : blk;
              attn_phase(lds, a, l, vcu, G, wave, lane); }
        } else {
            for (int rep = 0; rep <= DUP_LRU2; ++rep) lru_phase<true>(lds, a, l, blk, G, wave, lane);
        }
        if (DUP_SMASK) { if (!redo && ((DUP_SMASK >> s) & 1)) { redo = true; --ph; } else redo = false; }
    }
}

extern "C" void kernel_launch(void* const* d_in, const int* in_sizes, int n_in, void* d_out, int out_size, void* d_ws, size_t ws_size, hipStream_t stream) {
    static int grid = 0;
    if (grid == 0) {
        if (n_in != 21 || in_sizes[0] != MTOK * DM || out_size != MTOK * DM || ws_size < WS_END) { fprintf(stderr, "kernel_launch: unexpected shapes (n_in %d, in0 %d, out %d, ws %zu)\n", n_in, n_in > 0 ? in_sizes[0] : -1, out_size, ws_size); grid = -1; return; }
        int dev = 0, cus = 0, per_cu = 0;
        (void)hipGetDevice(&dev); (void)hipDeviceGetAttribute(&cus, hipDeviceAttributeMultiprocessorCount, dev);
        if (hipFuncSetAttribute((const void*)trunk_fwd, hipFuncAttributeMaxDynamicSharedMemorySize, LDS_BYTES) != hipSuccess) { fprintf(stderr, "kernel_launch: hipFuncSetAttribute failed\n"); grid = -1; return; }
        (void)hipOccupancyMaxActiveBlocksPerMultiprocessor(&per_cu, (const void*)trunk_fwd, 512, LDS_BYTES);
        (void)hipGetLastError();
        if (per_cu < 1) { fprintf(stderr, "kernel_launch: occupancy query says %d blocks/CU\n", per_cu); per_cu = 1; }
        grid = cus;
    }
    if (grid < 0) return;
    Args a{};
    for (int i = 0; i < 21; ++i) a.in[i] = (const float*)d_in[i];
    a.out = (float*)d_out; a.ws = (unsigned char*)d_ws;
#if MK_ONE_LAUNCH
    a.ph_lo = 0; a.ph_hi = NPH;
    void* args[] = {&a};
    if (hipMemsetAsync((char*)d_ws + WS_CTL, 0, CTL_BYTES, stream) != hipSuccess) { fprintf(stderr, "kernel_launch: memset of the barrier words failed\n"); return; }
    hipError_t e = hipLaunchCooperativeKernel((const void*)trunk_fwd, dim3(grid), dim3(512), args, LDS_BYTES, stream);
    if (e != hipSuccess) fprintf(stderr, "cooperative launch failed: %s (grid %d)\n", hipGetErrorString(e), grid);
#else
    for (int ph = 0; ph < NPH; ++ph) {
        a.ph_lo = ph; a.ph_hi = ph + 1;
        hipLaunchKernelGGL(trunk_fwd, dim3(grid), dim3(512), LDS_BYTES, stream, a);
    }
#endif
}
```

```cpp
#include <hip/hip_runtime.h>
#include <hip/hip_cooperative_groups.h>
#include <cstdio>
#include <cstdint>
namespace cg = cooperative_groups;

#ifndef MK_ONE_LAUNCH
#define MK_ONE_LAUNCH 1
#endif
#define DUP_UP 0
#define DUP_SMASK 0
#define DUP_IN 0
#define DUP_CONV 0
#define DUP_LRU1 0
#define DUP_ATT 0
#define DUP_LRU2 0

#define LAS __attribute__((address_space(3)))
typedef unsigned short bf16_t;
typedef short bf16x8 __attribute__((ext_vector_type(8)));
typedef short s16x4 __attribute__((ext_vector_type(4)));
typedef float f32x4 __attribute__((ext_vector_type(4)));
typedef float f32x2 __attribute__((ext_vector_type(2)));
typedef unsigned u32x4 __attribute__((ext_vector_type(4)));
typedef unsigned u32x2 __attribute__((ext_vector_type(2)));

constexpr int DM = 1024, NBATCH = 8, SEQ = 4096, DEPTH = 4, MTOK = NBATCH * SEQ;
constexpr int DFF = 2816, DIN = 3840, DLRU = 768;
constexpr int QOFF = 0, KOFF = 768, VOFF = 1536, LXOFF = 2304, LGOFF = 3072;
constexpr float RMS_EPS = 1e-6f, LOG2E = 1.4426950408889634f;
constexpr int NPH = 1 + 8 * DEPTH;

constexpr size_t MiB = 1u << 20;
constexpr size_t WS_ROWSQ = 0;
constexpr size_t WS_SUMM = 2 * MiB;
constexpr size_t WS_W = 4 * MiB;
constexpr size_t WS_XT = 48 * MiB;
#define XB_PTR(a) ((bf16_t*)((a).ws + 112 * MiB))
#define MIX_PTR(a) ((bf16_t*)(a).out + (size_t)MTOK * DM)
constexpr size_t WS_BIG = 176 * MiB;
constexpr size_t WS_END = 416 * MiB;
constexpr size_t W_GU1 = 0, W_D1 = W_GU1 + (size_t)2 * DFF * DM, W_IN = W_D1 + (size_t)DM * DFF, W_OUT = W_IN + (size_t)DIN * DM,
                 W_GU2 = W_OUT + (size_t)DM * DM, W_D2 = W_GU2 + (size_t)2 * DFF * DM, W_TOT = W_D2 + (size_t)DM * DFF;
static_assert(WS_W + W_TOT * 2 <= 48 * MiB, "weights fit");

constexpr int LDS_BYTES = 147456;

struct Args { const float* in[21]; float* out; unsigned char* ws; int ph_lo, ph_hi; };

__device__ __forceinline__ unsigned cvt_pk_bf16(float lo, float hi) { unsigned r; asm volatile("v_cvt_pk_bf16_f32 %0, %1, %2" : "=v"(r) : "v"(lo), "v"(hi)); return r; }
__device__ __forceinline__ float bf2f(unsigned short b) { return __uint_as_float(((unsigned)b) << 16); }
__device__ __forceinline__ float bflo(unsigned w) { return __uint_as_float(w << 16); }
__device__ __forceinline__ float bfhi(unsigned w) { return __uint_as_float(w & 0xffff0000u); }
__device__ __forceinline__ float fast_rcp(float x) { return __builtin_amdgcn_rcpf(x); }
__device__ __forceinline__ float fast_exp(float x) { return __builtin_amdgcn_exp2f(x * LOG2E); }
__device__ __forceinline__ float sigmoidf_(float x) { return fast_rcp(1.0f + fast_exp(-x)); }
__device__ __forceinline__ float wave_sum(float v) {
#pragma unroll
    for (int o = 1; o < 64; o <<= 1) v += __shfl_xor(v, o);
    return v;
}
__device__ __forceinline__ float wave_max(float v) {
#pragma unroll
    for (int o = 1; o < 64; o <<= 1) v = fmaxf(v, __shfl_xor(v, o));
    return v;
}
#define LDS_WAIT() asm volatile("s_waitcnt lgkmcnt(0)" ::: "memory")

namespace pg8 {
constexpr int BM = 256, BK = 64, HALF = 128, HTB = HALF * BK * 2, STAGE_BYTES = 8 * HTB, NXCD = 8, WGM = 8;
__host__ __device__ __forceinline__ int lds_byte(int r, int c) { const int st = (r >> 4) * 2 + (c >> 5), rr = r & 15, cc = c & 31, ob = rr * 64 + cc * 2; return st * 1024 + (ob ^ (((ob >> 9) & 1) << 5)); }
__host__ __device__ __forceinline__ void stage_rc(int b, int& R, int& C) { const int st = b / 1024, sb = b % 1024, swz = sb ^ (((sb >> 9) & 1) << 5); R = (st >> 1) * 16 + swz / 64; C = (st & 1) * 32 + (swz % 64) / 2; }
__host__ __device__ __forceinline__ int perm32(int rho) { const int n = rho >> 4, i = rho & 15; return 8 * (i >> 2) + 4 * n + (i & 3); }

struct Unit { int pm, pn; };
struct Gemm { const bf16_t* A; const bf16_t* Bt; int M, N, K; };

template <int NN>
struct StaticOrderT {
    static constexpr int nM = MTOK / BM, nN = NN, nwg = nM * nN;
    int G, c;
    __device__ void init(int G_, int c_) { G = G_; c = c_; }
    __device__ __forceinline__ bool next(int i, Unit& u) const {
        const int L = i * G + c; if (L >= nwg) return false;
        int wgid = L; { constexpr int q = nwg / NXCD, r = nwg % NXCD; const int xcd = wgid % NXCD, off = wgid / NXCD; wgid = (xcd < r ? xcd * (q + 1) : r * (q + 1) + (xcd - r) * q) + off; }
        constexpr int nig = WGM * nN; const int gid = wgid / nig, fm = gid * WGM, gsz = (nM - fm) < WGM ? (nM - fm) : WGM;
        u.pm = fm + ((wgid % nig) % gsz); u.pn = (wgid % nig) / gsz; return true;
    }
};

__device__ __forceinline__ float row_rstd(const float* rowsq, int r) {
    const f32x4* p = (const f32x4*)(rowsq + (size_t)r * 16); const f32x4 a = p[0], b = p[1], c = p[2], d = p[3];
    const float s = (((a[0] + a[1]) + (a[2] + a[3])) + ((b[0] + b[1]) + (b[2] + b[3]))) + (((c[0] + c[1]) + (c[2] + c[3])) + ((d[0] + d[1]) + (d[2] + d[3])));
    return __builtin_amdgcn_rsqf(s * (1.0f / DM) + RMS_EPS);
}
constexpr int RSTD_LDS = 131072;
struct EpiSwiGLU {
    static constexpr bool NEEDS_RSTD = true;
    bf16_t* H; const float* rowsq;
    __device__ __forceinline__ void operator()(const f32x4 (&acc)[2][2][4][2], const Unit& u, int wr, int wc, int fr, int fq, const LAS float* rstd) const {
        const int row0 = u.pm * BM + wr * 64 + fr, col0 = u.pn * HALF + wc * 32 + 8 * fq;
#pragma unroll
        for (int ai = 0; ai < 2; ++ai)
#pragma unroll
            for (int m = 0; m < 4; ++m) {
                const int r = row0 + ai * HALF + m * 16;
                const float rs = rstd[ai * HALF + wr * 64 + m * 16 + fr];
                float hv[8];
#pragma unroll
                for (int n = 0; n < 2; ++n)
#pragma unroll
                    for (int j = 0; j < 4; ++j) { const float g = acc[ai][0][m][n][j] * rs, up = acc[ai][1][m][n][j] * rs; hv[4 * n + j] = g * up * fast_rcp(1.0f + fast_exp(-g)); }
                u32x4 w; w.x = cvt_pk_bf16(hv[0], hv[1]); w.y = cvt_pk_bf16(hv[2], hv[3]); w.z = cvt_pk_bf16(hv[4], hv[5]); w.w = cvt_pk_bf16(hv[6], hv[7]);
                *(u32x4*)(H + (size_t)r * DFF + col0) = w;
            }
    }
};
struct EpiProj {
    static constexpr bool NEEDS_RSTD = true;
    bf16_t* O; int ldc; const float* rowsq;
    __device__ __forceinline__ void operator()(const f32x4 (&acc)[2][2][4][2], const Unit& u, int wr, int wc, int fr, int fq, const LAS float* rstd) const {
        const int row0 = u.pm * BM + wr * 64 + fr, col0 = u.pn * BM + wc * 32 + 8 * fq;
#pragma unroll
        for (int ai = 0; ai < 2; ++ai)
#pragma unroll
            for (int m = 0; m < 4; ++m) {
                const int r = row0 + ai * HALF + m * 16;
                const float rs = rstd[ai * HALF + wr * 64 + m * 16 + fr];
#pragma unroll
                for (int bj = 0; bj < 2; ++bj) {
                    const f32x4 v0 = acc[ai][bj][m][0] * rs, v1 = acc[ai][bj][m][1] * rs;
                    u32x4 w; w.x = cvt_pk_bf16(v0[0], v0[1]); w.y = cvt_pk_bf16(v0[2], v0[3]); w.z = cvt_pk_bf16(v1[0], v1[1]); w.w = cvt_pk_bf16(v1[2], v1[3]);
                    *(u32x4*)(O + (size_t)r * ldc + col0 + bj * HALF) = w;
                }
            }
    }
};
__host__ __device__ __forceinline__ size_t xt_off(int pm, int pn, int wid, int ai, int m, int bj, int hf, int lane) {
    return ((((((((size_t)(pm * 4 + pn) * 8 + wid) * 2 + ai) * 4 + m) * 2 + bj) * 2 + hf) * 64) + lane) * 4;
}
constexpr int LOB = 4;
__host__ __device__ __forceinline__ size_t lo_off(int pm, int pn, int wid, int ai, int m, int bj, int lane) {
    return (((((((size_t)(pm * 4 + pn) * 8 + wid) * 2 + ai) * 4 + m) * 2 + bj) * 64) + lane) * LOB;
}
__device__ __forceinline__ unsigned res_enc(float y) { return (__float_as_uint(y) + (1u << (15 - LOB))) >> (16 - LOB); }
__device__ __forceinline__ unsigned res_hi(unsigned bL) { return (bL + (1u << (LOB - 1))) >> LOB; }
struct EpiResid {
    static constexpr bool NEEDS_RSTD = false;
    unsigned char* LO; bf16_t* XB; float* rowsq_out; float alpha; const float* rowsq; float* OUT;
    __device__ __forceinline__ void operator()(const f32x4 (&acc)[2][2][4][2], const Unit& u, int wr, int wc, int fr, int fq, const LAS float* rstd) const {
        const int row0 = u.pm * BM + wr * 64 + fr, col0 = u.pn * BM + wc * 32 + 8 * fq, lane = fq * 16 + fr;
#pragma unroll
        for (int ai = 0; ai < 2; ++ai)
#pragma unroll
            for (int m = 0; m < 4; ++m) {
                const int r = row0 + ai * HALF + m * 16;
                unsigned char* lp = LO + lo_off(u.pm, u.pn, wr * 4 + wc, ai, m, 0, lane);
                bf16_t* hp = XB + (size_t)r * DM + col0;
                float ss = 0.f;
#pragma unroll
                for (int bj = 0; bj < 2; ++bj) {
                    const u32x4 hw = *(const u32x4*)(hp + bj * HALF);
                    unsigned lw[2]; if (LOB == 8) { const u32x2 t = *(const u32x2*)(lp + bj * 64 * LOB); lw[0] = t.x; lw[1] = t.y; } else { lw[0] = *(const unsigned*)(lp + bj * 64 * LOB); lw[1] = 0u; }
                    float y[8];
#pragma unroll
                    for (int e = 0; e < 8; ++e) {
                        const unsigned hpart = (e & 1) ? (hw[e >> 1] & 0xffff0000u) : (hw[e >> 1] << 16);
                        const unsigned w = (LOB == 8) ? lw[e >> 2] : lw[0]; const int pos = (LOB == 8) ? 8 * (e & 3) : 4 * e;
                        const int lo = ((int)(w << (32 - LOB - pos))) >> (32 - LOB);
                        y[e] = __uint_as_float(hpart + (unsigned)(lo << (16 - LOB))) + acc[ai][bj][m][e >> 2][e & 3] * alpha;
                    }
                    if (OUT) { float* rowp = OUT + (size_t)r * DM + col0 + bj * HALF; *(f32x4*)rowp = (f32x4){y[0], y[1], y[2], y[3]}; *(f32x4*)(rowp + 4) = (f32x4){y[4], y[5], y[6], y[7]}; }
                    else {
                        u32x4 nh; unsigned nl0 = 0u, nl1 = 0u;
#pragma unroll
                        for (int i = 0; i < 4; ++i) {
                            const unsigned b0 = res_enc(y[2 * i]), b1 = res_enc(y[2 * i + 1]);
                            ss += y[2 * i] * y[2 * i] + y[2 * i + 1] * y[2 * i + 1];
                            nh[i] = (res_hi(b0) & 0xffffu) | (res_hi(b1) << 16);
                            const unsigned pr = (b0 & ((1u << LOB) - 1u)) | ((b1 & ((1u << LOB) - 1u)) << LOB);
                            if (LOB == 8) { if (i < 2) nl0 |= pr << (16 * i); else nl1 |= pr << (16 * (i - 2)); } else nl0 |= pr << (8 * i);
                        }
                        *(u32x4*)(hp + bj * HALF) = nh;
                        if (LOB == 8) { u32x2 nl; nl.x = nl0; nl.y = nl1; *(u32x2*)(lp + bj * 64 * LOB) = nl; } else *(unsigned*)(lp + bj * 64 * LOB) = nl0;
                    }
                }
                if (!OUT) { ss += __shfl_xor(ss, 16); ss += __shfl_xor(ss, 32);
                    if (fq == 0) rowsq_out[(size_t)r * 16 + u.pn * 4 + wc] = ss; }
                asm volatile("" ::: "memory");
            }
    }
};

template <class Epi, class Sched>
__device__ __forceinline__ void gemm_phase(LAS unsigned char* lds, const Gemm g, const Sched& S, const Epi& E, const int tid) {
    const int wid = __builtin_amdgcn_readfirstlane(tid >> 6), lane = tid & 63, wr = wid >> 2, wc = wid & 3, fr = lane & 15, fq = lane >> 4;
    const int K = g.K, nt = K / BK;
    unsigned voffA[2], voffB[2];
#pragma unroll
    for (int i = 0; i < 2; ++i) { int R, C; stage_rc(tid * 16 + i * 8192, R, C); const int Rb = (R & ~31) + perm32(R & 31);
        voffA[i] = (unsigned)(R * K + C) * 2u; voffB[i] = (unsigned)(Rb * K + C) * 2u; }
    const size_t kstep = (size_t)(BK * 2);
    const size_t hstep = (size_t)HALF * K * 2;
    const size_t tstep = 2 * hstep;
    const unsigned ldsw = (unsigned)wid * 1024u;
    const int aoff = lds_byte(wr * 64 + fr, fq * 8), boff = lds_byte(wc * 32 + fr, fq * 8);
#define PG8_SA(b, h) (((b) * 2 + (h)) * HTB)
#define PG8_SB(b, h) ((4 + (b) * 2 + (h)) * HTB)
#define PG8_STAGE(bufoff, gbase, voff) do { _Pragma("unroll") for (int _i = 0; _i < 2; ++_i) \
        __builtin_amdgcn_global_load_lds((const unsigned*)((const char*)(gbase) + (voff)[_i]), (LAS unsigned*)(lds + (bufoff) + ldsw + _i * 8192), 16, 0, 0); } while (0)
#define PG8_LDA(dst, b, h) do { _Pragma("unroll") for (int m = 0; m < 4; ++m) _Pragma("unroll") for (int k = 0; k < 2; ++k) dst[m][k] = *(const LAS bf16x8*)(lds + PG8_SA(b, h) + aoff + m * 2048 + k * 1024); } while (0)
#define PG8_LDB(dst, b, h) do { _Pragma("unroll") for (int n = 0; n < 2; ++n) _Pragma("unroll") for (int k = 0; k < 2; ++k) dst[n][k] = *(const LAS bf16x8*)(lds + PG8_SB(b, h) + boff + n * 2048 + k * 1024); } while (0)
#define PG8_MMA(ai, bj, At, Bt) do { __builtin_amdgcn_s_setprio(3); _Pragma("unroll") for (int m = 0; m < 4; ++m) _Pragma("unroll") for (int n = 0; n < 2; ++n) _Pragma("unroll") for (int k = 0; k < 2; ++k) \
        acc[ai][bj][m][n] = __builtin_amdgcn_mfma_f32_16x16x32_bf16(Bt[n][k], At[m][k], acc[ai][bj][m][n], 0, 0, 0); __builtin_amdgcn_s_setprio(0); } while (0)
#define PG8_WAIT_V(n) asm volatile("s_waitcnt vmcnt(" #n ")" ::: "memory")
#define PG8_WAIT_L(n) asm volatile("s_waitcnt lgkmcnt(" #n ")" ::: "memory")
#define PG8_BAR __builtin_amdgcn_s_barrier()
#define PG8_SCHED __builtin_amdgcn_sched_barrier(0)
    Unit cur, nxt; int ui = 0;
    if (!S.next(0, cur)) return;
    f32x4 acc[2][2][4][2];
#pragma unroll
    for (int a = 0; a < 2; ++a)
#pragma unroll
        for (int b = 0; b < 2; ++b)
#pragma unroll
            for (int m = 0; m < 4; ++m)
#pragma unroll
                for (int n = 0; n < 2; ++n) acc[a][b][m][n] = (f32x4){0.f, 0.f, 0.f, 0.f};
    bf16x8 At[4][2], B0[2][2], B1[2][2];
    const char* cA = (const char*)g.A + (size_t)cur.pm * tstep; const char* cB = (const char*)g.Bt + (size_t)cur.pn * tstep;
    PG8_STAGE(PG8_SB(0, 0), cB, voffB); PG8_STAGE(PG8_SB(0, 1), cB + hstep, voffB); PG8_STAGE(PG8_SA(0, 0), cA, voffA); PG8_STAGE(PG8_SA(0, 1), cA + hstep, voffA);
    if (wr == 1) PG8_BAR;
    PG8_WAIT_V(2); PG8_BAR;
    PG8_STAGE(PG8_SB(1, 0), cB + kstep, voffB); PG8_STAGE(PG8_SA(1, 0), cA + kstep, voffA); PG8_STAGE(PG8_SB(1, 1), cB + hstep + kstep, voffB);
    PG8_WAIT_V(6); PG8_BAR;
    for (;;) {
        const bool has_next = S.next(ui + 1, nxt);
        const char* nA = has_next ? (const char*)g.A + (size_t)nxt.pm * tstep : cA; const char* nB = has_next ? (const char*)g.Bt + (size_t)nxt.pn * tstep : cB;
        for (int t = 0; t < nt; t += 2) {
            const bool last = (t == nt - 2);
            const char* a1 = cA + (size_t)(t + 1) * kstep;
            const char* a2 = last ? nA : cA + (size_t)(t + 2) * kstep; const char* b2 = last ? nB : cB + (size_t)(t + 2) * kstep;
            const char* a3 = a2 + kstep; const char* b3 = b2 + kstep;
            PG8_LDB(B0, 0, 0); PG8_LDB(B1, 0, 1); PG8_SCHED; PG8_LDA(At, 0, 0); PG8_STAGE(PG8_SA(1, 1), a1 + hstep, voffA);
            PG8_WAIT_V(8); PG8_WAIT_L(0); PG8_BAR; PG8_MMA(0, 0, At, B0); PG8_MMA(0, 1, At, B1); PG8_BAR; PG8_SCHED;
            PG8_LDA(At, 0, 1); PG8_STAGE(PG8_SB(0, 0), b2, voffB); PG8_STAGE(PG8_SB(0, 1), b2 + hstep, voffB); PG8_STAGE(PG8_SA(0, 0), a2, voffA);
            PG8_WAIT_V(8); PG8_WAIT_L(0); PG8_BAR; PG8_MMA(1, 0, At, B0); PG8_MMA(1, 1, At, B1); PG8_BAR; PG8_SCHED;
            PG8_LDB(B0, 1, 0); PG8_LDB(B1, 1, 1); PG8_SCHED; PG8_LDA(At, 1, 0); PG8_STAGE(PG8_SA(0, 1), a2 + hstep, voffA);
            PG8_WAIT_V(8); PG8_WAIT_L(0); PG8_BAR; PG8_MMA(0, 0, At, B0); PG8_MMA(0, 1, At, B1); PG8_BAR; PG8_SCHED;
            PG8_LDA(At, 1, 1); PG8_STAGE(PG8_SB(1, 0), b3, voffB); PG8_STAGE(PG8_SB(1, 1), b3 + hstep, voffB); PG8_STAGE(PG8_SA(1, 0), a3, voffA);
            PG8_WAIT_V(8); PG8_WAIT_L(0); PG8_BAR; PG8_MMA(1, 0, At, B0); PG8_MMA(1, 1, At, B1); PG8_BAR; PG8_SCHED;
        }
        if (wr == 0) PG8_BAR;
        if constexpr (Epi::NEEDS_RSTD) {
            if (tid < 256) ((LAS float*)(lds + RSTD_LDS))[tid] = row_rstd(E.rowsq, cur.pm * BM + tid);
            PG8_WAIT_L(0); PG8_BAR;
        }
        E(acc, cur, wr, wc, fr, fq, (const LAS float*)(lds + RSTD_LDS));
        if (!has_next) break;
#pragma unroll
        for (int a = 0; a < 2; ++a)
#pragma unroll
            for (int b = 0; b < 2; ++b)
#pragma unroll
                for (int m = 0; m < 4; ++m)
#pragma unroll
                    for (int n = 0; n < 2; ++n) acc[a][b][m][n] = (f32x4){0.f, 0.f, 0.f, 0.f};
        cur = nxt; cA = nA; cB = nB; ++ui;
        if (wr == 1) PG8_BAR;
    }
    PG8_WAIT_V(0);
    PG8_BAR;
#undef PG8_SA
#undef PG8_SB
#undef PG8_STAGE
#undef PG8_LDA
#undef PG8_LDB
#undef PG8_MMA
#undef PG8_WAIT_V
#undef PG8_WAIT_L
#undef PG8_BAR
#undef PG8_SCHED
}
}

__device__ __forceinline__ void transpose_item(const float* __restrict__ W, int K, int N, bf16_t* __restrict__ WT, const float* __restrict__ gain, int mode, LAS float* scr, int item, int lane) {
    (void)scr;
    const int nblk = N / 32, kb = item / nblk, nb = item % nblk, c = lane & 7, ng = lane >> 3, k0 = 64 * kb + 8 * c, n0 = 32 * nb + 4 * ng;
    f32x4 v[8];
#pragma unroll
    for (int j = 0; j < 8; ++j) v[j] = *(const f32x4*)(W + (size_t)(k0 + j) * N + n0);
    if (gain) { const f32x4 g0 = *(const f32x4*)(gain + k0), g1 = *(const f32x4*)(gain + k0 + 4);
#pragma unroll
        for (int j = 0; j < 4; ++j) { v[j] = v[j] * g0[j]; v[4 + j] = v[4 + j] * g1[j]; } }
#pragma unroll
    for (int i = 0; i < 4; ++i) { const int nn = n0 + i; const int drow = (mode == 0) ? nn : (256 * (nn >> 7) + (nn & 127) + (mode == 2 ? 128 : 0));
        u32x4 o; o.x = cvt_pk_bf16(v[0][i], v[1][i]); o.y = cvt_pk_bf16(v[2][i], v[3][i]); o.z = cvt_pk_bf16(v[4][i], v[5][i]); o.w = cvt_pk_bf16(v[6][i], v[7][i]);
        *(u32x4*)(WT + (size_t)drow * K + k0) = o; }
}
constexpr int IT_GU = (DM / 64) * (DFF / 32), IT_DN = (DFF / 64) * (DM / 32), IT_IN = (DM / 64) * (DIN / 32), IT_OUT = (DM / 64) * (DM / 32);
__device__ __forceinline__ void convert_part(const Args& a, int l, int part, LAS unsigned char* lds, int gw, int ngw, int wave, int lane) {
    LAS float* scr = (LAS float*)(lds + wave * 8448);
    bf16_t* wb = (bf16_t*)(a.ws + WS_W);
    if (part == 0) {
        constexpr int NIT = 3 * IT_GU + IT_IN;
        for (int it = gw; it < NIT; it += ngw) {
            int r = it;
            if (r < IT_GU) { transpose_item(a.in[2] + (size_t)l * DM * DFF, DM, DFF, wb + W_GU1, a.in[1] + l * DM, 1, scr, r, lane); continue; } r -= IT_GU;
            if (r < IT_GU) { transpose_item(a.in[3] + (size_t)l * DM * DFF, DM, DFF, wb + W_GU1, a.in[1] + l * DM, 2, scr, r, lane); continue; } r -= IT_GU;
            if (r < IT_DN) { transpose_item(a.in[4] + (size_t)l * DFF * DM, DFF, DM, wb + W_D1, nullptr, 0, scr, r, lane); continue; } r -= IT_DN;
            transpose_item(a.in[6] + (size_t)l * DM * DIN, DM, DIN, wb + W_IN, a.in[5] + l * DM, 0, scr, r, lane);
        }
    } else {
        constexpr int NIT = 3 * IT_GU + IT_OUT;
        for (int it = gw; it < NIT; it += ngw) {
            int r = it;
            if (r < IT_OUT) { transpose_item(a.in[16] + (size_t)l * DM * DM, DM, DM, wb + W_OUT, nullptr, 0, scr, r, lane); continue; } r -= IT_OUT;
            if (r < IT_GU) { transpose_item(a.in[18] + (size_t)l * DM * DFF, DM, DFF, wb + W_GU2, a.in[17] + l * DM, 1, scr, r, lane); continue; } r -= IT_GU;
            if (r < IT_GU) { transpose_item(a.in[19] + (size_t)l * DM * DFF, DM, DFF, wb + W_GU2, a.in[17] + l * DM, 2, scr, r, lane); continue; } r -= IT_GU;
            transpose_item(a.in[20] + (size_t)l * DFF * DM, DFF, DM, wb + W_D2, nullptr, 0, scr, r, lane);
        }
    }
}

__device__ __forceinline__ void p0_rows(const Args& a, int gw, int ngw, int lane) {
    const float* x = a.in[0]; bf16_t* xb = XB_PTR(a); float* rowsq = (float*)(a.ws + WS_ROWSQ); unsigned char* xlo = (unsigned char*)(a.ws + WS_XT);
    for (int m = gw; m < MTOK; m += ngw) {
        const f32x4* xr = (const f32x4*)(x + (size_t)m * DM) + lane;
        u32x2* brow = (u32x2*)(xb + (size_t)m * DM) + lane;
        const int pm = m >> 8, rr = m & 255, ai = rr >> 7, wr = (rr >> 6) & 1, mm = (rr >> 4) & 3, fr = rr & 15;
        float s = 0.f;
#pragma unroll
        for (int j = 0; j < 4; ++j) { const f32x4 v = xr[64 * j]; s += (v[0] * v[0] + v[1] * v[1]) + (v[2] * v[2] + v[3] * v[3]);
            const int c = 4 * lane + 256 * j, pn = c >> 8, cc = c & 255, bj = cc >> 7, wc = (cc >> 5) & 3, fq = (cc >> 3) & 3, hf = (cc >> 2) & 1;
            const unsigned b0 = pg8::res_enc(v[0]), b1 = pg8::res_enc(v[1]), b2 = pg8::res_enc(v[2]), b3 = pg8::res_enc(v[3]);
            u32x2 h; h.x = (pg8::res_hi(b0) & 0xffffu) | (pg8::res_hi(b1) << 16); h.y = (pg8::res_hi(b2) & 0xffffu) | (pg8::res_hi(b3) << 16);
            brow[64 * j] = h;
            unsigned char* lpp = xlo + pg8::lo_off(pm, pn, wr * 4 + wc, ai, mm, bj, fq * 16 + fr) + (pg8::LOB / 2) * hf;
            if (pg8::LOB == 8) *(unsigned*)lpp = (b0 & 0xffu) | ((b1 & 0xffu) << 8) | ((b2 & 0xffu) << 16) | (b3 << 24);
            else *(unsigned short*)lpp = (unsigned short)((b0 & 0xfu) | ((b1 & 0xfu) << 4) | ((b2 & 0xfu) << 8) | ((b3 & 0xfu) << 12)); }
        s = wave_sum(s);
        if (lane < 16) rowsq[(size_t)m * 16 + lane] = lane == 0 ? s : 0.f;
    }
}

constexpr int LRU_NITEMS = NBATCH * 12 * 32;
template <bool FINAL>
__device__ __forceinline__ void lru_phase(LAS unsigned char* lds, const Args& a, int l, int blk, int G, int wave, int lane) {
    const bf16_t* proj = (const bf16_t*)(a.ws + WS_BIG); bf16_t* mix = MIX_PTR(a); float* summ = (float*)(a.ws + WS_SUMM);
    LAS unsigned char* wl = lds + wave * 11264;
    LAS bf16_t* XC = (LAS bf16_t*)wl;
    LAS float* PRE = (LAS float*)(wl + 2304);
    LAS float* SEG = (LAS float*)(lds + 8 * 11264);
    LAS float* CARRY = SEG + 1024;
    const int fr = lane & 15, fq = lane >> 4;
    const int per = (LRU_NITEMS + G - 1) / G, it0 = blk * per, it1 = (it0 + per < LRU_NITEMS) ? it0 + per : LRU_NITEMS;
    int cur_seq = -1;
    bf16x8 Bf[2][4][2]; float cw0 = 0, cw1 = 0, cw2 = 0, cw3 = 0, cb = 0, ba = 0, bx = 0, sp = 0, ba2 = 0, bx2 = 0, c2 = 0;
    unsigned short xr[19], gr[16];
#define LRU_LOAD(itn) do { const int seq_ = (itn) >> 5, chunk_ = (itn) & 31, b_ = seq_ / 12, hb_ = seq_ - b_ * 12, t0_ = chunk_ * 128 + 16 * wave; \
        const bf16_t* xp_ = proj + (size_t)b_ * SEQ * DIN + LXOFF + hb_ * 64 + lane; \
        _Pragma("unroll") for (int i = 0; i < 19; ++i) { const int t = t0_ - 3 + i; xr[i] = xp_[(size_t)(t < 0 ? 0 : t) * DIN]; } \
        if (FINAL) { const bf16_t* gp_ = xp_ + (LGOFF - LXOFF); _Pragma("unroll") for (int i = 0; i < 16; ++i) gr[i] = gp_[(size_t)(t0_ + i) * DIN]; } } while (0)
    if (it0 < it1) LRU_LOAD(it0);
    for (int it = it0; it < it1; ++it) {
        const int seq = it >> 5, chunk = it & 31, b = seq / 12, hb = seq - b * 12;
        if (seq != cur_seq) {
            cur_seq = seq;
            const int ch = hb * 64 + lane;
            cw0 = a.in[9][(l * 4 + 0) * DLRU + ch]; cw1 = a.in[9][(l * 4 + 1) * DLRU + ch]; cw2 = a.in[9][(l * 4 + 2) * DLRU + ch]; cw3 = a.in[9][(l * 4 + 3) * DLRU + ch];
            cb = a.in[10][l * DLRU + ch]; ba = a.in[12][l * DLRU + ch]; bx = a.in[14][l * DLRU + ch];
            sp = log1pf(expf(-a.in[15][l * DLRU + ch]));
            ba2 = -ba * LOG2E; bx2 = -bx * LOG2E; c2 = -8.0f * sp * LOG2E;
#pragma unroll
            for (int gg = 0; gg < 2; ++gg) { const float* Wg = a.in[gg ? 13 : 11] + ((size_t)(l * 12 + hb)) * 4096;
#pragma unroll
                for (int nt = 0; nt < 4; ++nt)
#pragma unroll
                    for (int ks = 0; ks < 2; ++ks) { float wv[8];
#pragma unroll
                        for (int jj = 0; jj < 8; ++jj) wv[jj] = Wg[(32 * ks + 8 * fq + jj) * 64 + 16 * nt + fr];
                        u32x4 w; w.x = cvt_pk_bf16(wv[0], wv[1]); w.y = cvt_pk_bf16(wv[2], wv[3]); w.z = cvt_pk_bf16(wv[4], wv[5]); w.w = cvt_pk_bf16(wv[6], wv[7]);
                        Bf[gg][nt][ks] = __builtin_bit_cast(bf16x8, w); } }
            if (FINAL) {
                __syncthreads();
                { const float* sp_ = summ + (size_t)seq * 32 * 128 + lane; float av[4], bv[4];
#pragma unroll
                  for (int k = 0; k < 4; ++k) { const int cc = 4 * wave + k; const float A = sp_[cc * 128], B = sp_[cc * 128 + 64]; av[k] = cc < chunk ? A : 1.f; bv[k] = cc < chunk ? B : 0.f; }
                  float A = 1.f, B = 0.f;
#pragma unroll
                  for (int k = 0; k < 4; ++k) { B = av[k] * B + bv[k]; A *= av[k]; }
                  SEG[(wave * 2 + 0) * 64 + lane] = A; SEG[(wave * 2 + 1) * 64 + lane] = B; }
                __syncthreads();
                if (wave == 0) { float h = 0.f;
#pragma unroll
                    for (int s2 = 0; s2 < 8; ++s2) h = SEG[(s2 * 2) * 64 + lane] * h + SEG[(s2 * 2 + 1) * 64 + lane];
                    CARRY[lane] = h; }
                __syncthreads();
            }
        }
        const int t0 = chunk * 128 + 16 * wave;
        float xv[19];
#pragma unroll
        for (int i = 0; i < 19; ++i) xv[i] = (t0 - 3 + i) < 0 ? 0.f : bf2f(xr[i]);
        float gv[16];
        if (FINAL) {
#pragma unroll
            for (int i = 0; i < 16; ++i) gv[i] = bf2f(gr[i]);
        }
        if (it + 1 < it1) LRU_LOAD(it + 1);
        float xc[16];
#pragma unroll
        for (int i = 0; i < 16; ++i) { xc[i] = cb + cw0 * xv[i] + cw1 * xv[i + 1] + cw2 * xv[i + 2] + cw3 * xv[i + 3]; XC[i * 72 + lane] = (bf16_t)(cvt_pk_bf16(xc[i], 0.f) & 0xffffu); }
        LDS_WAIT();
        bf16x8 af[2];
#pragma unroll
        for (int ks = 0; ks < 2; ++ks) af[ks] = *(const LAS bf16x8*)((const LAS unsigned char*)XC + fr * 144 + fq * 16 + ks * 64);
#pragma unroll
        for (int gg = 0; gg < 2; ++gg)
#pragma unroll
            for (int nt = 0; nt < 4; ++nt) { f32x4 c = (f32x4){0.f, 0.f, 0.f, 0.f};
#pragma unroll
                for (int ks = 0; ks < 2; ++ks) c = __builtin_amdgcn_mfma_f32_16x16x32_bf16(af[ks], Bf[gg][nt][ks], c, 0, 0, 0);
#pragma unroll
                for (int rg = 0; rg < 4; ++rg) PRE[gg * 16 * 68 + (4 * fq + rg) * 68 + 16 * nt + fr] = c[rg]; }
        LDS_WAIT();
        float h = 0.f, P = 1.f; float hl[16], Pl[16];
#pragma unroll
        for (int i = 0; i < 16; ++i) {
            const float r = fast_rcp(1.0f + __builtin_amdgcn_exp2f(__builtin_fmaf(PRE[i * 68 + lane], -LOG2E, ba2)));
            const float ig = fast_rcp(1.0f + __builtin_amdgcn_exp2f(__builtin_fmaf(PRE[16 * 68 + i * 68 + lane], -LOG2E, bx2)));
            const float aa = __builtin_amdgcn_exp2f(r * c2);
            const float bb = __builtin_sqrtf(fmaxf(1.0f - aa * aa, 0.f)) * ig * xc[i];
            h = aa * h + bb; P *= aa; hl[i] = h; Pl[i] = P;
        }
        SEG[(wave * 2 + 0) * 64 + lane] = P; SEG[(wave * 2 + 1) * 64 + lane] = h;
        __syncthreads();
        if (FINAL) {
            float hin = CARRY[lane];
            for (int s = 0; s < wave; ++s) hin = SEG[(s * 2) * 64 + lane] * hin + SEG[(s * 2 + 1) * 64 + lane];
            bf16_t* yp = mix + ((size_t)b * SEQ + t0) * DM + 256 + hb * 64 + lane;
#pragma unroll
            for (int i = 0; i < 16; ++i) { const float hv = hl[i] + Pl[i] * hin; const float g = gv[i];
                const float w2 = g * __builtin_fmaf(g * g, -1.5957691216f * 0.044715f * LOG2E, -1.5957691216f * LOG2E);
                const float y = hv * g * fast_rcp(1.0f + __builtin_amdgcn_exp2f(w2));
                yp[(size_t)i * DM] = (bf16_t)(cvt_pk_bf16(y, 0.f) & 0xffffu); }
            const float hout = P * hin + h;
            __syncthreads();
            if (wave == 7) CARRY[lane] = hout;
        } else {
            if (wave == 0) { float A = 1.f, B = 0.f;
#pragma unroll
                for (int s = 0; s < 8; ++s) { const float As = SEG[(s * 2) * 64 + lane], Bs = SEG[(s * 2 + 1) * 64 + lane]; B = As * B + Bs; A *= As; }
                float* sp_ = summ + ((size_t)seq * 32 + chunk) * 128 + lane; sp_[0] = A; sp_[64] = B; }
            __syncthreads();
        }
    }
#undef LRU_LOAD
    __syncthreads();
}

__device__ __forceinline__ float sumsq8(bf16x8 v) { const u32x4 w = __builtin_bit_cast(u32x4, v); float s = 0.f;
#pragma unroll
    for (int i = 0; i < 4; ++i) { const float lo = bflo(w[i]), hi = bfhi(w[i]); s += lo * lo + hi * hi; } return s; }
__device__ __forceinline__ s16x4 vtr(const LAS unsigned char* p) { typedef short v4i16_t __attribute__((ext_vector_type(4))); return __builtin_amdgcn_ds_read_tr16_b64_v4i16((LAS v4i16_t*)p); }

struct AttJob { const bf16_t* base; int rsh, rho, i0, koff, voff, qoff; };
constexpr int ATT_NITEMS = NBATCH * 4 * (SEQ / 256);
__device__ __forceinline__ AttJob att_make_job(const bf16_t* proj, int it, int jidx, int wave) {
    const int tile = it & 15, hs = (it >> 4) & 3, b = it >> 6, g = jidx >> 1, jb = jidx & 1;
    AttJob J; J.rsh = 2 * g; const int r = 1 << J.rsh, j = 2 * wave + jb; J.rho = j & (r - 1); const int sub = j >> J.rsh;
    J.i0 = ((tile * 256) >> J.rsh) + 16 * sub; J.base = proj + (size_t)b * SEQ * DIN;
    J.qoff = QOFF + g * 256 + hs * 64; J.koff = KOFF + g * 256 + hs * 64; J.voff = VOFF + g * 256 + hs * 64; return J;
}
__device__ __forceinline__ void attn_phase(LAS unsigned char* lds, const Args& a, int l, int vcu, int G, int wave, int lane) {
    const bf16_t* proj = (const bf16_t*)(a.ws + WS_BIG); bf16_t* mix = MIX_PTR(a);
    LAS float* O = (LAS float*)lds;
    LAS float* Z = (LAS float*)(lds + 256 * 68 * 4);
    LAS unsigned char* Vst = lds + 256 * 68 * 4 + 1024 + wave * 4608;
    const int fr = lane & 15, fq = lane >> 4, tid = wave * 64 + lane;
    const float* gq = a.in[7] + l * 64; const float* gk = a.in[8] + l * 64;
    const float mshift = 8.0f * wave_max(fabsf(gq[lane])) * wave_max(fabsf(gk[lane])) * LOG2E;
    LAS float* GQK = (LAS float*)(lds + 256 * 68 * 4 + 1024 + 8 * 4608);
    if (wave == 0) GQK[lane] = gq[lane] * gk[lane] * (0.125f * LOG2E);
    __syncthreads();
    if (vcu >= ATT_NITEMS) return;
    bf16x8 kf[5][2][2], vv[5][4], qn[2];
#define ATT_ISSUE_K(buf, J, p) do { \
        _Pragma("unroll") for (int aa = ((p) == 0 ? 1 : 0); aa < 2; ++aa) { const int ik = (J).i0 - 144 + 32 * (p) + 16 * aa + fr; const int ikc = ik < 0 ? 0 : ik; \
            const bf16_t* kp = (J).base + (size_t)((J).rho + (ikc << (J).rsh)) * DIN + (J).koff + 8 * fq; \
            kf[buf][aa][0] = *(const bf16x8*)kp; kf[buf][aa][1] = *(const bf16x8*)(kp + 32); } } while (0)
#define ATT_ISSUE_V(buf, J, p) do { \
        _Pragma("unroll") for (int i = 0; i < 4; ++i) { const int idx = lane + 64 * i, kk = idx >> 3, ch = idx & 7; const int ik = (J).i0 - 144 + 32 * (p) + kk; const int ikc = ik < 0 ? 0 : ik; \
            vv[buf][i] = *(const bf16x8*)((J).base + (size_t)((J).rho + (ikc << (J).rsh)) * DIN + (J).voff + 8 * ch); } } while (0)
#define ATT_ISSUE_Q(J) do { const bf16_t* qp = (J).base + (size_t)((J).rho + (((J).i0 + fr) << (J).rsh)) * DIN + (J).qoff + 8 * fq; qn[0] = *(const bf16x8*)qp; qn[1] = *(const bf16x8*)(qp + 32); } while (0)
    AttJob Jc = att_make_job(proj, vcu, 0, wave);
    ATT_ISSUE_Q(Jc); ATT_ISSUE_K(0, Jc, 0); ATT_ISSUE_V(0, Jc, 0); ATT_ISSUE_K(1, Jc, 1); ATT_ISSUE_K(2, Jc, 2);
    for (int it = vcu; it < ATT_NITEMS; it += G) {
        const int tile = it & 15, hs = (it >> 4) & 3, b = it >> 6, t0 = tile * 256;
        for (int jidx = 0; jidx < 6; ++jidx) {
            const int g = jidx >> 1;
            const bool has_next = (jidx < 5) || (it + G < ATT_NITEMS);
            const AttJob Jn = att_make_job(proj, (jidx < 5 || !has_next) ? it : it + G, jidx < 5 ? jidx + 1 : (has_next ? 0 : 5), wave);
            const float slope2 = exp2f(-8.0f * (float)(4 * g + hs + 1) / 12.0f) * (float)(1 << Jc.rsh) * LOG2E;
            bf16x8 qf[2];
            {
                const bf16x8 q0 = qn[0], q1 = qn[1];
                float ss = sumsq8(q0) + sumsq8(q1); ss += __shfl_xor(ss, 16); ss += __shfl_xor(ss, 32);
                const float rq = __builtin_amdgcn_rsqf(ss * (1.0f / 64.0f) + RMS_EPS);
                const u32x4 w0 = __builtin_bit_cast(u32x4, q0), w1 = __builtin_bit_cast(u32x4, q1); u32x4 o0, o1;
                const LAS f32x4* gp = (const LAS f32x4*)(GQK + 8 * fq);
                const f32x4 ga = gp[0] * rq, gb = gp[1] * rq, gc = gp[8] * rq, gd = gp[9] * rq;
                o0[0] = cvt_pk_bf16(bflo(w0[0]) * ga[0], bfhi(w0[0]) * ga[1]); o0[1] = cvt_pk_bf16(bflo(w0[1]) * ga[2], bfhi(w0[1]) * ga[3]);
                o0[2] = cvt_pk_bf16(bflo(w0[2]) * gb[0], bfhi(w0[2]) * gb[1]); o0[3] = cvt_pk_bf16(bflo(w0[3]) * gb[2], bfhi(w0[3]) * gb[3]);
                o1[0] = cvt_pk_bf16(bflo(w1[0]) * gc[0], bfhi(w1[0]) * gc[1]); o1[1] = cvt_pk_bf16(bflo(w1[1]) * gc[2], bfhi(w1[1]) * gc[3]);
                o1[2] = cvt_pk_bf16(bflo(w1[2]) * gd[0], bfhi(w1[2]) * gd[1]); o1[3] = cvt_pk_bf16(bflo(w1[3]) * gd[2], bfhi(w1[3]) * gd[3]);
                qf[0] = __builtin_bit_cast(bf16x8, o0); qf[1] = __builtin_bit_cast(bf16x8, o1);
            }
            f32x4 oacc[4];
#pragma unroll
            for (int dt = 0; dt < 4; ++dt) oacc[dt] = (f32x4){0.f, 0.f, 0.f, 0.f};
            float zsum = 0.f;
            const float laneb = -slope2 * (float)(fr - 4 * fq) - mshift;
#pragma unroll
            for (int p = 0; p < 5; ++p) {
                if (p + 3 < 5) { ATT_ISSUE_K(p + 3, Jc, p + 3); } else { ATT_ISSUE_K((p + 3) % 5, Jn, p + 3 - 5); }
                if (p + 1 < 5) { ATT_ISSUE_V(p + 1, Jc, p + 1); } else { ATT_ISSUE_V(0, Jn, 0); }
                if (p == 4) ATT_ISSUE_Q(Jn);
                const int ikb = Jc.i0 - 144 + 32 * p;
                float pv[2][4];
#pragma unroll
                for (int aa = 0; aa < 2; ++aa) {
                    if (p == 0 && aa == 0) { pv[0][0] = 0.f; pv[0][1] = 0.f; pv[0][2] = 0.f; pv[0][3] = 0.f; continue; }
                    const bf16x8 k0 = kf[p][aa][0], k1 = kf[p][aa][1];
                    f32x4 sc = (f32x4){0.f, 0.f, 0.f, 0.f};
                    sc = __builtin_amdgcn_mfma_f32_16x16x32_bf16(k0, qf[0], sc, 0, 0, 0);
                    sc = __builtin_amdgcn_mfma_f32_16x16x32_bf16(k1, qf[1], sc, 0, 0, 0);
                    f32x4 kk2 = (f32x4){0.f, 0.f, 0.f, 0.f};
                    kk2 = __builtin_amdgcn_mfma_f32_16x16x32_bf16(k0, k0, kk2, 0, 0, 0);
                    kk2 = __builtin_amdgcn_mfma_f32_16x16x32_bf16(k1, k1, kk2, 0, 0, 0);
                    const int base = 144 - 32 * p - 16 * aa;
                    const bool chk_hi = (p == 0 && aa == 1), chk_lo = (p == 4 && aa == 1);
#pragma unroll
                    for (int rg = 0; rg < 4; ++rg) {
                        const float rkk = __builtin_amdgcn_rsqf(__shfl(kk2[rg], 20 * fq + rg) * (1.0f / 64.0f) + RMS_EPS);
                        const int ik = ikb + 16 * aa + 4 * fq + rg;
                        bool valid = (ik >= 0);
                        if (chk_hi) valid = valid && (fr - 4 * fq - rg + base <= 128);
                        if (chk_lo) valid = valid && (fr - 4 * fq - rg + base >= 0);
                        const float e = __builtin_fmaf(sc[rg], rkk, __builtin_fmaf(-slope2, (float)(base - rg), laneb));
                        const float pe = valid ? __builtin_amdgcn_exp2f(e) : 0.f;
                        pv[aa][rg] = pe; zsum += pe;
                    }
                }
                u32x4 pw; pw.x = cvt_pk_bf16(pv[0][0], pv[0][1]); pw.y = cvt_pk_bf16(pv[0][2], pv[0][3]); pw.z = cvt_pk_bf16(pv[1][0], pv[1][1]); pw.w = cvt_pk_bf16(pv[1][2], pv[1][3]);
                const bf16x8 pb = __builtin_bit_cast(bf16x8, pw);
#pragma unroll
                for (int i = 0; i < 4; ++i) { const int idx = lane + 64 * i, kk = idx >> 3, ch = idx & 7; *(LAS bf16x8*)(Vst + kk * 144 + ch * 16) = vv[p][i]; }
                LDS_WAIT();
                const LAS unsigned char* vb = Vst + (4 * fq + (fr >> 2)) * 144 + (fr & 3) * 8;
#pragma unroll
                for (int dt = 0; dt < 4; ++dt) {
                    const s16x4 lo = vtr(vb + dt * 32), hi = vtr(vb + 16 * 144 + dt * 32);
                    const bf16x8 va = (bf16x8){lo[0], lo[1], lo[2], lo[3], hi[0], hi[1], hi[2], hi[3]};
                    oacc[dt] = __builtin_amdgcn_mfma_f32_16x16x32_bf16(va, pb, oacc[dt], 0, 0, 0);
                }
                LDS_WAIT();
                asm volatile("" ::: "memory");
            }
            zsum += __shfl_xor(zsum, 16); zsum += __shfl_xor(zsum, 32);
            const int tl = Jc.rho + (((Jc.i0 - (t0 >> Jc.rsh)) + fr) << Jc.rsh);
            LAS f32x4* op = (LAS f32x4*)(O + tl * 68 + 4 * fq);
            if (g == 0) {
#pragma unroll
                for (int dt = 0; dt < 4; ++dt) op[4 * dt] = oacc[dt];
                if (fq == 0) Z[tl] = zsum;
            } else {
#pragma unroll
                for (int dt = 0; dt < 4; ++dt) { const f32x4 o = op[4 * dt]; op[4 * dt] = o + oacc[dt]; }
                if (fq == 0) Z[tl] += zsum;
            }
            Jc = Jn;
            if (jidx & 1) __syncthreads();
        }
        {
            const int tok = tid >> 1, half = tid & 1;
            const float inv = 1.0f / Z[tok];
            const LAS f32x4* op = (const LAS f32x4*)(O + tok * 68 + 32 * half);
            bf16_t* dst = mix + ((size_t)b * SEQ + t0 + tok) * DM + hs * 64 + 32 * half;
#pragma unroll
            for (int i = 0; i < 4; ++i) { const f32x4 v0 = op[2 * i] * inv, v1 = op[2 * i + 1] * inv;
                u32x4 w; w.x = cvt_pk_bf16(v0[0], v0[1]); w.y = cvt_pk_bf16(v0[2], v0[3]); w.z = cvt_pk_bf16(v1[0], v1[1]); w.w = cvt_pk_bf16(v1[2], v1[3]);
                *(u32x4*)(dst + 8 * i) = w; }
        }
        __syncthreads();
    }
#undef ATT_ISSUE_K
#undef ATT_ISSUE_V
#undef ATT_ISSUE_Q
}


constexpr size_t WS_CTL = 3 * MiB + 512 * 1024;
constexpr int CTL_BYTES = 16384;
constexpr int LDS_MISC = 140000;
#define XB_TMO      128
#define XB_XCNT(j)  (256  + 64 * (j))
#define XB_XSUB(j)  (1280 + 64 * (j))
#define XB_XGEN(j)  (2304 + 64 * (j))
#define XB_TOP      3328
#define XB_TOPGEN   3392
#define XB_SPIN_CAP (1u << 18)
__device__ __forceinline__ unsigned xb_ld(unsigned* p)              { return __hip_atomic_load(p, __ATOMIC_RELAXED, __HIP_MEMORY_SCOPE_AGENT); }
__device__ __forceinline__ unsigned xb_add(unsigned* p, unsigned v) { return __hip_atomic_fetch_add(p, v, __ATOMIC_RELAXED, __HIP_MEMORY_SCOPE_AGENT); }
__device__ __forceinline__ unsigned xb_xcc_id() { return (unsigned)__builtin_amdgcn_s_getreg((3 << 11) | 20) & 0xFu; }
#define XB_SPIN(cond, bar) do { unsigned _sp = 0; while (cond) { __builtin_amdgcn_s_sleep(1); \
    if ((++_sp & 255u) == 0u) { if (xb_ld(&(bar)[XB_TMO])) break; if (_sp > XB_SPIN_CAP) { atomicAdd(&(bar)[XB_TMO], 1u); break; } } } } while (0)
__device__ __forceinline__ void xcd_barrier_complete(unsigned* bar, unsigned x, unsigned& nloc, unsigned& nx) {
    const unsigned G = gridDim.x * gridDim.y * gridDim.z;
    unsigned sum, cnt, mine, sp = 0u;
    for (;;) {
        sum = 0u; cnt = 0u; mine = 0u;
#pragma unroll
        for (unsigned j = 0; j < 16; ++j) { const unsigned c = xb_ld(&bar[XB_XCNT(j)]); sum += c; cnt += (c > 0u) ? 1u : 0u; mine = (j == x) ? c : mine; }
        if (sum == G) break;
        __builtin_amdgcn_s_sleep(1);
        if ((++sp & 255u) == 0u) { if (xb_ld(&bar[XB_TMO])) break; if (sp > XB_SPIN_CAP) { atomicAdd(&bar[XB_TMO], 1u); break; } }
    }
    nloc = mine > 0u ? mine : 1u; nx = cnt > 0u ? cnt : 1u;
}
__device__ __forceinline__ void xcd_barrier(unsigned* bar, volatile LAS unsigned* st) {
    asm volatile("s_waitcnt vmcnt(0)" ::: "memory");
    __syncthreads();
    if (threadIdx.x == 0) {
        __builtin_amdgcn_s_waitcnt(0);
        const unsigned x = xb_xcc_id();
        unsigned nloc = st[0], nx = st[1];
        if (nloc == 0u) { xcd_barrier_complete(bar, x, nloc, nx); st[0] = nloc; st[1] = nx; }
        const unsigned old = xb_add(&bar[XB_XSUB(x)], 1u);
        const unsigned gen = old / nloc;
        if (old + 1u == (gen + 1u) * nloc) {
            __builtin_amdgcn_fence(__ATOMIC_RELEASE, "agent");
            asm volatile("s_waitcnt vmcnt(0)" ::: "memory");
            const unsigned og = xb_add(&bar[XB_TOP], 1u);
            const unsigned tg = og / nx;
            if (og + 1u == (tg + 1u) * nx) xb_add(&bar[XB_TOPGEN], 1u);
            else XB_SPIN(xb_ld(&bar[XB_TOPGEN]) == tg, bar);
            __builtin_amdgcn_fence(__ATOMIC_ACQUIRE, "agent");
            xb_add(&bar[XB_XGEN(x)], 1u);
            asm volatile("s_waitcnt vmcnt(0)" ::: "memory");
        } else {
            XB_SPIN(xb_ld(&bar[XB_XGEN(x)]) == gen, bar);
            __builtin_amdgcn_fence(__ATOMIC_ACQUIRE, "agent");
            asm volatile("s_waitcnt vmcnt(0)" ::: "memory");
        }
    }
    __syncthreads();
}

__global__ void __launch_bounds__(512, 2) trunk_fwd(Args a) {
    extern __shared__ __attribute__((aligned(16))) unsigned char lds_raw[];
    LAS unsigned char* lds = (LAS unsigned char*)lds_raw;
    cg::grid_group grid = cg::this_grid();
    unsigned* barw = (unsigned*)(a.ws + WS_CTL);
    volatile LAS unsigned* bst = (volatile LAS unsigned*)(lds + LDS_MISC);
    if (threadIdx.x == 0) { bst[0] = 0u; bst[1] = 0u; if (a.ph_hi - a.ph_lo > 1) (void)xb_add(&barw[XB_XCNT(xb_xcc_id())], 1u); }
    __syncthreads();
    bool redo = false; int nseam = 0;
    for (int ph = a.ph_lo; ph < a.ph_hi; ++ph) {
        if (a.ph_lo < 0) grid.sync();
        if (nseam >= 1) xcd_barrier(barw, bst);
        ++nseam;

        int tid = threadIdx.x; asm volatile("" : "+v"(tid));
        int G = gridDim.x, blk = blockIdx.x; asm volatile("" : "+s"(G), "+s"(blk));
        unsigned char* wsb = a.ws; asm volatile("" : "+s"(wsb));
        const int lane = tid & 63, wave = __builtin_amdgcn_readfirstlane(tid >> 6);
        const int gw = blk * 8 + wave, ngw = G * 8;
        bf16_t* wb = (bf16_t*)(wsb + WS_W); bf16_t* xb = XB_PTR(a); bf16_t* mixb = MIX_PTR(a); bf16_t* big = (bf16_t*)(wsb + WS_BIG);
        float* rowsq = (float*)(wsb + WS_ROWSQ);
        if (ph == 0) { p0_rows(a, gw, ngw, lane); convert_part(a, 0, 0, lds, gw, ngw, wave, lane); continue; }
        const int l = (ph - 1) >> 3, s = (ph - 1) & 7;
        if (s == 0 || s == 6) {
            pg8::Gemm g{xb, wb + (s == 0 ? W_GU1 : W_GU2), MTOK, 2 * DFF, DM}; pg8::StaticOrderT<2 * DFF / 256> S; S.init(G, blk);
            pg8::EpiSwiGLU E{big, rowsq};
            pg8::gemm_phase<pg8::EpiSwiGLU, pg8::StaticOrderT<2 * DFF / 256>>(lds, g, S, E, tid);
        } else if (s == 1 || s == 7 || s == 5) {
            const bool isout = (s == 5);
            pg8::Gemm g{isout ? mixb : big, wb + (s == 1 ? W_D1 : (s == 7 ? W_D2 : W_OUT)), MTOK, DM, isout ? DM : DFF}; pg8::StaticOrderT<DM / 256> S; S.init(G, blk);
            pg8::EpiResid E{(unsigned char*)(wsb + WS_XT), xb, rowsq, isout ? 1.0f : 0.5f, nullptr, (ph == NPH - 1) ? a.out : nullptr};
            pg8::gemm_phase<pg8::EpiResid, pg8::StaticOrderT<DM / 256>>(lds, g, S, E, tid);
        } else if (s == 2) {
            pg8::Gemm g{xb, wb + W_IN, MTOK, DIN, DM}; pg8::StaticOrderT<DIN / 256> S; S.init(G, blk);
            pg8::EpiProj E{big, DIN, rowsq};
            pg8::gemm_phase<pg8::EpiProj, pg8::StaticOrderT<DIN / 256>>(lds, g, S, E, tid);
            { const int nun = (MTOK / 256) * (DIN / 256), nx = nun - (nun / G) * G;
              if (nx > 0 && blk >= nx) convert_part(a, l, 1, lds, (blk - nx) * 8 + wave, (G - nx) * 8, wave, lane); }
        } else if (s == 3) {
            for (int rep = 0; rep <= DUP_ATT; ++rep)
            { const int vcu = (G % 8 == 0) ? (blk % 8) * (G / 8) + blk / 8 : blk;
              attn_phase(lds, a, l, vcu, G, wave, lane); }
            __syncthreads();
            for (int rep = 0; rep <= DUP_LRU1; ++rep) lru_phase<false>(lds, a, l, blk, G, wave, lane);
            for (int rep = 0; rep <= DUP_CONV; ++rep) {
            { const int nun = (MTOK / 256) * (DIN / 256); if (nun % G == 0) convert_part(a, l, 1, lds, gw, ngw, wave, lane); }
            if (l + 1 < DEPTH) convert_part(a, l + 1, 0, lds, gw, ngw, wave, lane);
            __syncthreads(); }
        } else {
            for (int rep = 0; rep <= DUP_LRU2; ++rep) lru_phase<true>(lds, a, l, blk, G, wave, lane);
        }
        if (DUP_SMASK) { if (!redo && ((DUP_SMASK >> s) & 1)) { redo = true; --ph; } else redo = false; }
    }
}

extern "C" void kernel_launch(void* const* d_in, const int* in_sizes, int n_in, void* d_out, int out_size, void* d_ws, size_t ws_size, hipStream_t stream) {
    static int grid = 0;
    if (grid == 0) {
        if (n_in != 21 || in_sizes[0] != MTOK * DM || out_size != MTOK * DM || ws_size < WS_END) { fprintf(stderr, "kernel_launch: unexpected shapes (n_in %d, in0 %d, out %d, ws %zu)\n", n_in, n_in > 0 ? in_sizes[0] : -1, out_size, ws_size); grid = -1; return; }
        int dev = 0, cus = 0, per_cu = 0;
        (void)hipGetDevice(&dev); (void)hipDeviceGetAttribute(&cus, hipDeviceAttributeMultiprocessorCount, dev);
        if (hipFuncSetAttribute((const void*)trunk_fwd, hipFuncAttributeMaxDynamicSharedMemorySize, LDS_BYTES) != hipSuccess) { fprintf(stderr, "kernel_launch: hipFuncSetAttribute failed\n"); grid = -1; return; }
        (void)hipOccupancyMaxActiveBlocksPerMultiprocessor(&per_cu, (const void*)trunk_fwd, 512, LDS_BYTES);
        (void)hipGetLastError();
        if (per_cu < 1) { fprintf(stderr, "kernel_launch: occupancy query says %d blocks/CU\n", per_cu); per_cu = 1; }
        grid = cus;
    }
    if (grid < 0) return;
    Args a{};
    for (int i = 0; i < 21; ++i) a.in[i] = (const float*)d_in[i];
    a.out = (float*)d_out; a.ws = (unsigned char*)d_ws;
#if MK_ONE_LAUNCH
    a.ph_lo = 0; a.ph_hi = NPH;
    void* args[] = {&a};
    if (hipMemsetAsync((char*)d_ws + WS_CTL, 0, CTL_BYTES, stream) != hipSuccess) { fprintf(stderr, "kernel_launch: memset of the barrier words failed\n"); return; }
    hipError_t e = hipLaunchCooperativeKernel((const void*)trunk_fwd, dim3(grid), dim3(512), args, LDS_BYTES, stream);
    if (e != hipSuccess) fprintf(stderr, "cooperative launch failed: %s (grid %d)\n", hipGetErrorString(e), grid);
#else
    for (int ph = 0; ph < NPH; ++ph) {
        a.ph_lo = ph; a.ph_hi = ph + 1;
        hipLaunchKernelGGL(trunk_fwd, dim3(grid), dim3(512), LDS_BYTES, stream, a);
    }
#endif
}
```
